# Optimizing an MI355X kernel written in HIP

```python
import math
import jax
import jax.numpy as jnp
from jax import lax
import numpy as np


D_MODEL = 1024
BATCH = 8
SEQ = 2048
DEPTH = 2

CTX_LEN = 256
GRID_W = 64
ROPE_BASE = 10000.0
Q_BLOCK = 128
EPS = 1e-6
NEG_INF = -1e30

MLA_HEADS = 8
MLA_Q_RANK = 384
MLA_KV_RANK = 256
MLA_NOPE = 64
MLA_ROPE = 32
MLA_V = 64
SWA_HEADS = 8
SWA_KV_HEADS = 2
SWA_HEAD_DIM = 64
WINDOW = 128
DIFF_HEADS = 8
DIFF_HALF = 64
DIFF_V = 128
N_EXPERTS = 64
N_GROUPS = 8
TOPK_GROUPS = 4
TOP_K = 8
EXPERT_FF = 256
SHARED_FF = 256
ROUTED_SCALE = 2.5
MOE_BLOCK = 128

EVEN_SPLITS = [MLA_Q_RANK, MLA_KV_RANK, MLA_ROPE, SWA_HEADS * SWA_HEAD_DIM,
               SWA_KV_HEADS * SWA_HEAD_DIM, SWA_KV_HEADS * SWA_HEAD_DIM]
EVEN_IN = sum(EVEN_SPLITS)
EVEN_OUT = MLA_HEADS * MLA_V + SWA_HEADS * SWA_HEAD_DIM
ODD_IN = DIFF_HEADS * (4 * DIFF_HALF + DIFF_V)
ODD_OUT = DIFF_HEADS * DIFF_V
N_EVEN = (DEPTH + 1) // 2
N_ODD = DEPTH // 2

kernel_name = 'hybrid_mla_swa_diffattn_moe_dit'


def split_last(x, sizes):
    points = [int(p) for p in np.cumsum(sizes)[:-1]]
    return jnp.split(x, points, axis=-1)


def rmsnorm(x, g):
    xf = x.astype(jnp.float32)
    y = xf * lax.rsqrt(jnp.mean(xf * xf, axis=-1, keepdims=True) + EPS)
    return (y * g.astype(jnp.float32)).astype(x.dtype)


def modulate(h, shift, scale):
    return h * (1 + scale) + shift


def axial_rope_tables(rows, rot_dim):
    half = rot_dim // 2
    inv_freq = ROPE_BASE ** (-jnp.arange(0, half, 2, dtype=jnp.float32) / half)
    row = jnp.repeat(jnp.arange(rows, dtype=jnp.float32), GRID_W)
    col = jnp.tile(jnp.arange(GRID_W, dtype=jnp.float32), rows)
    ang_r = row[:, None] * inv_freq
    ang_c = col[:, None] * inv_freq
    ang = jnp.concatenate([ang_r, ang_r, ang_c, ang_c], axis=-1)
    return jnp.cos(ang), jnp.sin(ang)


def rotate_half(x):
    x1, x2 = jnp.split(x, 2, axis=-1)
    return jnp.concatenate([-x2, x1], axis=-1)


def apply_rope(x, cos, sin):
    x_r, x_c = jnp.split(x, 2, axis=-1)
    rot = jnp.concatenate([rotate_half(x_r), rotate_half(x_c)], axis=-1)
    return (x * cos[None, :, None, :] + rot * sin[None, :, None, :]).astype(x.dtype)


def full_attention(q, k, v):
    s = jnp.einsum('bqhd,bkhd->bhqk', q, k).astype(jnp.float32) * (q.shape[-1] ** -0.5)
    p = jax.nn.softmax(s, axis=-1).astype(v.dtype)
    return jnp.einsum('bhqk,bkhd->bqhd', p, v)


def sweep_query_blocks(fn, *qs):
    b, n = qs[0].shape[:2]
    nb = n // Q_BLOCK
    blocks = tuple(jnp.moveaxis(q.reshape((b, nb, Q_BLOCK) + q.shape[2:]), 1, 0) for q in qs)
    out = lax.map(lambda qb: fn(*qb), blocks)
    out = jnp.moveaxis(out, 0, 1)
    return out.reshape((b, n) + out.shape[3:])


def softmax_with_sink(s, sink):
    m = jnp.maximum(s.max(axis=-1, keepdims=True), sink)
    e = jnp.exp(s - m)
    return e / (e.sum(axis=-1, keepdims=True) + jnp.exp(sink - m))


def window_sink_attention(q, k, v, k_ctx, v_ctx, sink):
    b, n, hq, d = q.shape
    nb = n // Q_BLOCK
    g = hq // SWA_KV_HEADS
    qb = q.reshape(b, nb, Q_BLOCK, SWA_KV_HEADS, g, d)

    def band(t):
        tp = jnp.pad(t, ((0, 0), (Q_BLOCK, Q_BLOCK), (0, 0), (0, 0)))
        tp = tp.reshape(b, nb + 2, Q_BLOCK, SWA_KV_HEADS, d)
        return jnp.concatenate([tp[:, :-2], tp[:, 1:-1], tp[:, 2:]], axis=2)

    kb, vb = band(k), band(v)
    qq = jnp.arange(Q_BLOCK)[:, None]
    kk = jnp.arange(3 * Q_BLOCK)[None, :]
    rel = kk - Q_BLOCK - qq
    key_pos = jnp.arange(nb)[:, None, None] * Q_BLOCK - Q_BLOCK + kk[None]
    valid = (jnp.abs(rel) <= WINDOW)[None] & (key_pos >= 0) & (key_pos < n)
    scale = d ** -0.5
    s_band = jnp.einsum('bnqhgd,bnkhd->bnhgqk', qb, kb).astype(jnp.float32) * scale
    s_band = jnp.where(valid[None, :, None, None], s_band, NEG_INF)
    s_ctx = jnp.einsum('bnqhgd,bchd->bnhgqc', qb, k_ctx).astype(jnp.float32) * scale
    s = jnp.concatenate([s_band, s_ctx], axis=-1)
    sink_l = sink.astype(jnp.float32).reshape(SWA_KV_HEADS, g)[:, :, None, None]
    p = softmax_with_sink(s, sink_l).astype(v.dtype)
    p_band, p_ctx = p[..., :3 * Q_BLOCK], p[..., 3 * Q_BLOCK:]
    o = (jnp.einsum('bnhgqk,bnkhd->bnqhgd', p_band, vb)
         + jnp.einsum('bnhgqc,bchd->bnqhgd', p_ctx, v_ctx))
    return o.reshape(b, n, hq, d)


def ctx_sink_attention(q, k, v, sink):
    b, n, hq, d = q.shape
    g = hq // SWA_KV_HEADS
    qg = q.reshape(b, n, SWA_KV_HEADS, g, d)
    s = jnp.einsum('bqhgd,bkhd->bhgqk', qg, k).astype(jnp.float32) * (d ** -0.5)
    sink_l = sink.astype(jnp.float32).reshape(SWA_KV_HEADS, g)[:, :, None, None]
    p = softmax_with_sink(s, sink_l).astype(v.dtype)
    return jnp.einsum('bhgqk,bkhd->bqhgd', p, v).reshape(b, n, hq, d)


def even_mixer(a_lat, a_ctx, rope_mla, rope_swa, w_in, g_q, g_kv, w_uq, w_ukv, sink, w_out, ctx_out):
    def project(a):
        b, n = a.shape[:2]
        cq, ckv, kr, qs, ks, vs = split_last(a @ w_in, EVEN_SPLITS)
        q = (rmsnorm(cq, g_q) @ w_uq).reshape(b, n, MLA_HEADS, MLA_NOPE + MLA_ROPE)
        kv = (rmsnorm(ckv, g_kv) @ w_ukv).reshape(b, n, MLA_HEADS, MLA_NOPE + MLA_V)
        q_nope, q_rope = split_last(q, [MLA_NOPE, MLA_ROPE])
        k_nope, v_m = split_last(kv, [MLA_NOPE, MLA_V])
        return (q_nope, q_rope, k_nope, kr[:, :, None, :], v_m,
                qs.reshape(b, n, SWA_HEADS, SWA_HEAD_DIM),
                ks.reshape(b, n, SWA_KV_HEADS, SWA_HEAD_DIM),
                vs.reshape(b, n, SWA_KV_HEADS, SWA_HEAD_DIM))

    def mla_qk(q_nope, q_rope, k_nope, k_rope):
        q = jnp.concatenate([q_nope, q_rope], axis=-1)
        k_rope_h = jnp.broadcast_to(k_rope, k_nope.shape[:3] + (MLA_ROPE,))
        return q, jnp.concatenate([k_nope, k_rope_h], axis=-1)

    b, n = a_lat.shape[:2]
    lq_n, lq_r, lk_n, lk_r, lv_m, lq_s, lk_s, lv_s = project(a_lat)
    cq_n, cq_r, ck_n, ck_r, cv_m, cq_s, ck_s, cv_s = project(a_ctx)
    lq_m, lk_m = mla_qk(lq_n, apply_rope(lq_r, *rope_mla), lk_n, apply_rope(lk_r, *rope_mla))
    ck_m = mla_qk(cq_n, cq_r, ck_n, ck_r)[1]
    lq_s = apply_rope(lq_s, *rope_swa)
    lk_s = apply_rope(lk_s, *rope_swa)
    k_all = jnp.concatenate([ck_m, lk_m], axis=1)
    v_all = jnp.concatenate([cv_m, lv_m], axis=1)
    o_mla = sweep_query_blocks(lambda qb: full_attention(qb, k_all, v_all), lq_m)
    o_swa = window_sink_attention(lq_s, lk_s, lv_s, ck_s, cv_s, sink)
    y_lat = jnp.concatenate([o_mla.reshape(b, n, -1), o_swa.reshape(b, n, -1)], axis=-1) @ w_out
    y_ctx = None
    if ctx_out:
        bc, nc = a_ctx.shape[:2]
        cq_m = mla_qk(cq_n, cq_r, ck_n, ck_r)[0]
        o_mla_c = full_attention(cq_m, ck_m, cv_m)
        o_swa_c = ctx_sink_attention(cq_s, ck_s, cv_s, sink)
        y_ctx = jnp.concatenate([o_mla_c.reshape(bc, nc, -1), o_swa_c.reshape(bc, nc, -1)], axis=-1) @ w_out
    return y_lat, y_ctx


def diff_attention(q1, q2, k1, k2, v, lam):
    scale = q1.shape[-1] ** -0.5
    a1 = jax.nn.softmax(jnp.einsum('bqhd,bkhd->bhqk', q1, k1).astype(jnp.float32) * scale, axis=-1)
    a2 = jax.nn.softmax(jnp.einsum('bqhd,bkhd->bhqk', q2, k2).astype(jnp.float32) * scale, axis=-1)
    return jnp.einsum('bhqk,bkhd->bqhd', (a1 - lam * a2).astype(v.dtype), v)


def odd_mixer(a_lat, a_ctx, rope, w_in, lam_q1, lam_k1, lam_q2, lam_k2, g_sub, w_out, lam_init, ctx_out):
    def project(a):
        b, n = a.shape[:2]
        p = (a @ w_in).reshape(b, n, DIFF_HEADS, 4 * DIFF_HALF + DIFF_V)
        return split_last(p, [DIFF_HALF] * 4 + [DIFF_V])

    def finish(o):
        b, n = o.shape[:2]
        o = rmsnorm(o, g_sub) * (1.0 - lam_init)
        return o.reshape(b, n, ODD_OUT) @ w_out

    f32 = jnp.float32
    lam = (jnp.exp(jnp.sum(lam_q1.astype(f32) * lam_k1.astype(f32)))
           - jnp.exp(jnp.sum(lam_q2.astype(f32) * lam_k2.astype(f32))) + lam_init)
    lq1, lq2, lk1, lk2, lv = project(a_lat)
    cq1, cq2, ck1, ck2, cv = project(a_ctx)
    lq1, lq2, lk1, lk2 = (apply_rope(t, *rope) for t in (lq1, lq2, lk1, lk2))
    k1_all = jnp.concatenate([ck1, lk1], axis=1)
    k2_all = jnp.concatenate([ck2, lk2], axis=1)
    v_all = jnp.concatenate([cv, lv], axis=1)
    o_lat = sweep_query_blocks(lambda a, b: diff_attention(a, b, k1_all, k2_all, v_all, lam), lq1, lq2)
    y_lat = finish(o_lat)
    y_ctx = None
    if ctx_out:
        y_ctx = finish(diff_attention(cq1, cq2, ck1, ck2, cv, lam))
    return y_lat, y_ctx


def route(xf, w_router, b_router):
    n = xf.shape[0]
    scores = jax.nn.sigmoid((xf @ w_router).astype(jnp.float32))
    biased = scores + b_router.astype(jnp.float32)
    grouped = biased.reshape(n, N_GROUPS, N_EXPERTS // N_GROUPS)
    group_score = lax.top_k(grouped, 2)[0].sum(axis=-1)
    _, keep = lax.top_k(group_score, TOPK_GROUPS)
    group_mask = jax.nn.one_hot(keep, N_GROUPS, dtype=jnp.float32).sum(axis=1) > 0
    expert_mask = jnp.repeat(group_mask, N_EXPERTS // N_GROUPS, axis=1)
    _, top_idx = lax.top_k(jnp.where(expert_mask, biased, NEG_INF), TOP_K)
    top_s = jnp.take_along_axis(scores, top_idx, axis=1)
    top_w = top_s / top_s.sum(axis=-1, keepdims=True) * ROUTED_SCALE
    return top_idx, top_w


def routed_experts(xf, top_idx, top_w, w_gate, w_up, w_down):
    n_tok, d = xf.shape
    n_assign = n_tok * TOP_K
    n_slots = ((n_assign + MOE_BLOCK - 1) // MOE_BLOCK + N_EXPERTS) * MOE_BLOCK
    n_blocks = n_slots // MOE_BLOCK
    e_flat = top_idx.reshape(-1)
    order = jnp.argsort(e_flat)
    e_sorted = e_flat[order]
    counts = jnp.bincount(e_flat, length=N_EXPERTS)
    padded = (counts + MOE_BLOCK - 1) // MOE_BLOCK * MOE_BLOCK
    pad_end = jnp.cumsum(padded)
    pad_start = pad_end - padded
    raw_start = jnp.cumsum(counts) - counts
    dest = pad_start[e_sorted] + jnp.arange(n_assign) - raw_start[e_sorted]
    slot_tok = jnp.full((n_slots,), n_tok, jnp.int32).at[dest].set((order // TOP_K).astype(jnp.int32))
    slot_w = jnp.zeros((n_slots,), xf.dtype).at[dest].set(top_w.reshape(-1)[order].astype(xf.dtype))
    block_expert = jnp.minimum(
        jnp.searchsorted(pad_end, jnp.arange(n_blocks) * MOE_BLOCK, side='right'), N_EXPERTS - 1)
    x_pad = jnp.concatenate([xf, jnp.zeros((1, d), xf.dtype)], axis=0)

    def body(acc, blk):
        tok, w, e = blk
        xb = x_pad[tok]
        h = jax.nn.silu(xb @ w_gate[e]) * (xb @ w_up[e])
        return acc.at[tok].add((h @ w_down[e]) * w[:, None]), None

    acc, _ = lax.scan(body, jnp.zeros_like(x_pad),
                      (slot_tok.reshape(n_blocks, MOE_BLOCK), slot_w.reshape(n_blocks, MOE_BLOCK), block_expert))
    return acc[:n_tok]


def moe_ffn(xf, w_router, b_router, we_gate, we_up, we_down, ws_gate, ws_up, ws_down):
    top_idx, top_w = route(xf, w_router, b_router)
    routed = routed_experts(xf, top_idx, top_w, we_gate, we_up, we_down)
    shared = (jax.nn.silu(xf @ ws_gate) * (xf @ ws_up)) @ ws_down
    return routed + shared


def setup_inputs(seed: int = 0) -> dict:
    key = jax.random.key(seed)
    ks = iter(jax.random.split(key, 32))
    D = D_MODEL

    def nrm(shape, scale=1.0):
        return jax.random.normal(next(ks), shape, jnp.float32) * scale

    def gain(shape):
        return 1.0 + nrm(shape, 0.02)

    return {
        'x': nrm((BATCH, SEQ, D)),
        'c': nrm((BATCH, D)),
        'ctx': nrm((BATCH, CTX_LEN, D)),
        'c_ctx': nrm((D,)),
        'w_ada': nrm((DEPTH, D, 6 * D), 0.5 * D ** -0.5),
        'b_ada': nrm((DEPTH, 6 * D), 0.02),
        'g_mix': gain((DEPTH, D)),
        'g_ffn': gain((DEPTH, D)),
        'wa_in': nrm((N_EVEN, D, EVEN_IN), D ** -0.5),
        'ga_q': gain((N_EVEN, MLA_Q_RANK)),
        'ga_kv': gain((N_EVEN, MLA_KV_RANK)),
        'wa_uq': nrm((N_EVEN, MLA_Q_RANK, MLA_HEADS * (MLA_NOPE + MLA_ROPE)), MLA_Q_RANK ** -0.5),
        'wa_ukv': nrm((N_EVEN, MLA_KV_RANK, MLA_HEADS * (MLA_NOPE + MLA_V)), MLA_KV_RANK ** -0.5),
        'wa_sink': nrm((N_EVEN, SWA_HEADS)),
        'wa_out': nrm((N_EVEN, EVEN_OUT, D), EVEN_OUT ** -0.5),
        'wc_in': nrm((N_ODD, D, ODD_IN), D ** -0.5),
        'lam_q1': nrm((N_ODD, DIFF_HALF), 0.1),
        'lam_k1': nrm((N_ODD, DIFF_HALF), 0.1),
        'lam_q2': nrm((N_ODD, DIFF_HALF), 0.1),
        'lam_k2': nrm((N_ODD, DIFF_HALF), 0.1),
        'gc_sub': gain((N_ODD, DIFF_V)),
        'wc_out': nrm((N_ODD, ODD_OUT, D), ODD_OUT ** -0.5),
        'w_router': nrm((DEPTH, D, N_EXPERTS), D ** -0.5),
        'b_router': nrm((DEPTH, N_EXPERTS), 0.01),
        'we_gate': nrm((DEPTH, N_EXPERTS, D, EXPERT_FF), D ** -0.5),
        'we_up': nrm((DEPTH, N_EXPERTS, D, EXPERT_FF), D ** -0.5),
        'we_down': nrm((DEPTH, N_EXPERTS, EXPERT_FF, D), EXPERT_FF ** -0.5),
        'ws_gate': nrm((DEPTH, D, SHARED_FF), D ** -0.5),
        'ws_up': nrm((DEPTH, D, SHARED_FF), D ** -0.5),
        'ws_down': nrm((DEPTH, SHARED_FF, D), SHARED_FF ** -0.5),
        'g_final': gain((D,)),
    }


def reference(x, c, ctx, c_ctx, w_ada, b_ada, g_mix, g_ffn, wa_in, ga_q, ga_kv, wa_uq, wa_ukv,
              wa_sink, wa_out, wc_in, lam_q1, lam_k1, lam_q2, lam_k2, gc_sub, wc_out, w_router,
              b_router, we_gate, we_up, we_down, ws_gate, ws_up, ws_down, g_final):
    b, n, d = x.shape
    n_ctx = ctx.shape[1]
    rows = n // GRID_W
    rope_mla = axial_rope_tables(rows, MLA_ROPE)
    rope_64 = axial_rope_tables(rows, SWA_HEAD_DIM)
    h_lat, h_ctx = x, ctx
    for layer in range(DEPTH):
        last = layer == DEPTH - 1
        mod_l = (jax.nn.silu(c) @ w_ada[layer] + b_ada[layer])[:, None, :]
        mod_c = (jax.nn.silu(c_ctx) @ w_ada[layer] + b_ada[layer])[None, None, :]
        sh_ml, sc_ml, gt_ml, sh_fl, sc_fl, gt_fl = jnp.split(mod_l, 6, axis=-1)
        sh_mc, sc_mc, gt_mc, sh_fc, sc_fc, gt_fc = jnp.split(mod_c, 6, axis=-1)
        a_lat = modulate(rmsnorm(h_lat, g_mix[layer]), sh_ml, sc_ml)
        a_ctx = modulate(rmsnorm(h_ctx, g_mix[layer]), sh_mc, sc_mc)
        if layer % 2 == 0:
            i = layer // 2
            y_lat, y_ctx = even_mixer(a_lat, a_ctx, rope_mla, rope_64, wa_in[i], ga_q[i], ga_kv[i],
                                      wa_uq[i], wa_ukv[i], wa_sink[i], wa_out[i], not last)
        else:
            i = layer // 2
            lam_init = 0.8 - 0.6 * math.exp(-0.3 * layer)
            y_lat, y_ctx = odd_mixer(a_lat, a_ctx, rope_64, wc_in[i], lam_q1[i], lam_k1[i],
                                     lam_q2[i], lam_k2[i], gc_sub[i], wc_out[i], lam_init, not last)
        h_lat = h_lat + gt_ml * y_lat
        f_lat = modulate(rmsnorm(h_lat, g_ffn[layer]), sh_fl, sc_fl).reshape(b * n, d)
        moe_args = (w_router[layer], b_router[layer], we_gate[layer], we_up[layer], we_down[layer],
                    ws_gate[layer], ws_up[layer], ws_down[layer])
        if last:
            y = moe_ffn(f_lat, *moe_args)
            h_lat = h_lat + gt_fl * y.reshape(b, n, d)
        else:
            h_ctx = h_ctx + gt_mc * y_ctx
            f_ctx = modulate(rmsnorm(h_ctx, g_ffn[layer]), sh_fc, sc_fc).reshape(b * n_ctx, d)
            y = moe_ffn(jnp.concatenate([f_lat, f_ctx], axis=0), *moe_args)
            h_lat = h_lat + gt_fl * y[:b * n].reshape(b, n, d)
            h_ctx = h_ctx + gt_fc * y[b * n:].reshape(b, n_ctx, d)
    return rmsnorm(h_lat, g_final)
```

```cpp
#include <hip/hip_runtime.h>
#include <cstdio>
#include <cstdint>

__device__ __forceinline__ int lane_id() { int l; asm volatile("v_mbcnt_lo_u32_b32 %0, -1, 0\n\tv_mbcnt_hi_u32_b32 %0, -1, %0" : "=v"(l)); return l; }
#define RDS 0
#ifndef MK_SINGLE
#define MK_SINGLE 1
#endif

constexpr int DM = 1024, NB = 8, SEQ = 2048, CTXL = 256;
constexpr int NLAT = NB * SEQ;
constexpr int NCTX = NB * CTXL;
constexpr int NT = NLAT + NCTX;
constexpr int NEXP = 64, FF = 256;
constexpr float EPS = 1e-6f;
constexpr int NPH = 18;

namespace pg8 {
#define PG8_LAS __attribute__((address_space(3)))
typedef unsigned short bf16_t;
typedef short bf16x8 __attribute__((ext_vector_type(8)));
typedef float f32x4 __attribute__((ext_vector_type(4)));
typedef unsigned u32x4 __attribute__((ext_vector_type(4)));
constexpr int BM = 256, BK = 64, HALF = 128, HTB = HALF * BK * 2, STAGE_BYTES = 8 * HTB, NXCD = 8, WGM = 8;

__host__ __device__ __forceinline__ int lds_byte(int r, int c) { const int st = (r >> 4) * 2 + (c >> 5), rr = r & 15, cc = c & 31, ob = rr * 64 + cc * 2; return st * 1024 + (ob ^ (((ob >> 9) & 1) << 5)); }
__host__ __device__ __forceinline__ void stage_rc(int b, int& R, int& C) { const int st = b / 1024, sb = b % 1024, swz = sb ^ (((sb >> 9) & 1) << 5); R = (st >> 1) * 16 + swz / 64; C = (st & 1) * 32 + (swz % 64) / 2; }
__host__ __device__ __forceinline__ int perm32(int rho) { const int n = rho >> 4, i = rho & 15; return 8 * (i >> 2) + 4 * n + (i & 3); }

struct Unit { int pm, pn, e, r; };
struct Gemm { const bf16_t* A; const bf16_t* Bt; int K; };

struct StaticOrder {
    int nM, nN, nwg, G, c;
    __device__ __forceinline__ void init(int M, int N, int G_, int c_) { nM = M / BM; nN = N / BM; nwg = nM * nN; G = G_; c = c_; }
    __device__ __forceinline__ bool next(int i, Unit& u) const {
        const long L = (long)i * G + c; if (L >= nwg) return false;
        int wgid = (int)L; { const int q = nwg / NXCD, r = nwg % NXCD, xcd = wgid % NXCD, off = wgid / NXCD; wgid = (xcd < r ? xcd * (q + 1) : r * (q + 1) + (xcd - r) * q) + off; }
        const int nig = WGM * nN, gid = wgid / nig, fm = gid * WGM, gsz = (nM - fm) < WGM ? (nM - fm) : WGM;
        u.pm = fm + ((wgid % nig) % gsz); u.pn = (wgid % nig) / gsz; u.e = 0; u.r = i; return true;
    }
    __device__ __forceinline__ unsigned row_off(const Unit&, int) const { return 0u; }
};

__device__ __forceinline__ unsigned cvt_pk_bf16(float lo, float hi) { unsigned r; asm volatile("v_cvt_pk_bf16_f32 %0, %1, %2" : "=v"(r) : "v"(lo), "v"(hi)); return r; }

template <class E, class = void> struct epi_wide { static constexpr bool value = false; };
template <class E> struct epi_wide<E, decltype((void)E::WIDE)> { static constexpr bool value = E::WIDE; };
template <class Epi, class Sched, bool ALIGN_EPI, bool GATHER>
__device__ __forceinline__ void gemm_phase(PG8_LAS unsigned char* lds, const Gemm g, const Sched& S, const Epi& E, const int wid) {
    const int lane = lane_id(), tid = wid * 64 + lane, wr = wid >> 2, wc = wid & 3, fr = lane & 15, fq = lane >> 4;
    const int K = g.K, nt = K / BK;
    unsigned voffA[2], voffB[2]; int Rr[2]; int Cc = 0;
    constexpr bool WIDE = epi_wide<Epi>::value;
#pragma unroll
    for (int i = 0; i < 2; ++i) { int R, C; stage_rc(tid * 16 + i * 8192, R, C); const int Rb = WIDE ? (64 * (R >> 5) + perm32(R & 31)) : (Epi::PERM ? ((R & ~31) + perm32(R & 31)) : R);
        voffA[i] = (unsigned)(R * K + C) * 2u; voffB[i] = (unsigned)(Rb * K + C) * 2u; Rr[i] = R; Cc = C; }
    const size_t kstep = (size_t)(BK * 2);
    const size_t hstep = (size_t)HALF * K * 2;
    const size_t tstep = 2 * hstep;
    const size_t hstepB = WIDE ? (size_t)32 * K * 2 : hstep;
    const unsigned ldsw = (unsigned)wid * 1024u;
    const int aoff = lds_byte(wr * 64 + fr, fq * 8), boff = lds_byte(wc * 32 + fr, fq * 8);
#define PG8_SA(b, h) (((b) * 2 + (h)) * HTB)
#define PG8_SB(b, h) ((4 + (b) * 2 + (h)) * HTB)
#define PG8_STAGE(bufoff, gbase, voff) do { _Pragma("unroll") for (int _i = 0; _i < 2; ++_i) \
        __builtin_amdgcn_global_load_lds((const unsigned*)((const char*)(gbase) + (voff)[_i]), (PG8_LAS unsigned*)(lds + (bufoff) + ldsw + _i * 8192), 16, 0, 0); } while (0)
#define PG8_STAGE_A(bufoff, ub, kb, h) do { if constexpr (GATHER) { _Pragma("unroll") for (int _i = 0; _i < 2; ++_i) \
        __builtin_amdgcn_global_load_lds((const unsigned*)((const char*)g.A + (size_t)gA[h][_i] + (kb)), (PG8_LAS unsigned*)(lds + (bufoff) + ldsw + _i * 8192), 16, 0, 0); } \
        else { PG8_STAGE(bufoff, (ub) + (kb) + (h) * hstep, voffA); } } while (0)
#define PG8_LDA(dst, b, h) do { _Pragma("unroll") for (int m = 0; m < 4; ++m) _Pragma("unroll") for (int k = 0; k < 2; ++k) dst[m][k] = *(const PG8_LAS bf16x8*)(lds + PG8_SA(b, h) + aoff + m * 2048 + k * 1024); } while (0)
#define PG8_LDB(dst, b, h) do { _Pragma("unroll") for (int n = 0; n < 2; ++n) _Pragma("unroll") for (int k = 0; k < 2; ++k) dst[n][k] = *(const PG8_LAS bf16x8*)(lds + PG8_SB(b, h) + boff + n * 2048 + k * 1024); } while (0)
#define PG8_MMA(ai, bj, At, Bt) do { __builtin_amdgcn_s_setprio(1); _Pragma("unroll") for (int m = 0; m < 4; ++m) _Pragma("unroll") for (int n = 0; n < 2; ++n) _Pragma("unroll") for (int k = 0; k < 2; ++k) \
        acc[ai][bj][m][n] = __builtin_amdgcn_mfma_f32_16x16x32_bf16(Bt[n][k], At[m][k], acc[ai][bj][m][n], 0, 0, 0); __builtin_amdgcn_s_setprio(0); } while (0)
#define PG8_WAIT_V(n) asm volatile("s_waitcnt vmcnt(" #n ")" ::: "memory")
#define PG8_WAIT_L(n) asm volatile("s_waitcnt lgkmcnt(" #n ")" ::: "memory")
#define PG8_BAR __builtin_amdgcn_s_barrier()
#define PG8_SCHED __builtin_amdgcn_sched_barrier(0)
    Unit cur, nxt; int ui = 0;
    if (!S.next(0, cur)) return;
    unsigned gA[2][2] = {{0u, 0u}, {0u, 0u}};
    if constexpr (GATHER) {
#pragma unroll
        for (int h = 0; h < 2; ++h)
#pragma unroll
            for (int i = 0; i < 2; ++i) gA[h][i] = S.row_off(cur, h * HALF + Rr[i]) + (unsigned)Cc * 2u;
    }
    f32x4 acc[2][2][4][2];
#pragma unroll
    for (int a = 0; a < 2; ++a)
#pragma unroll
        for (int b = 0; b < 2; ++b)
#pragma unroll
            for (int m = 0; m < 4; ++m)
#pragma unroll
                for (int n = 0; n < 2; ++n) acc[a][b][m][n] = (f32x4){0.f, 0.f, 0.f, 0.f};
    bf16x8 At[4][2], B0[2][2], B1[2][2];
    const char* cA = (const char*)g.A + (GATHER ? (size_t)0 : (size_t)cur.pm * tstep); const char* cB = (const char*)g.Bt + (size_t)cur.pn * tstep;
    PG8_STAGE(PG8_SB(0, 0), cB, voffB); PG8_STAGE(PG8_SB(0, 1), cB + hstepB, voffB); PG8_STAGE_A(PG8_SA(0, 0), cA, 0, 0); PG8_STAGE_A(PG8_SA(0, 1), cA, 0, 1);
    if (wr == 1) PG8_BAR;
    PG8_WAIT_V(2); PG8_BAR;
    PG8_STAGE(PG8_SB(1, 0), cB + kstep, voffB); PG8_STAGE_A(PG8_SA(1, 0), cA, kstep, 0); PG8_STAGE(PG8_SB(1, 1), cB + hstepB + kstep, voffB);
    PG8_WAIT_V(6); PG8_BAR;
    for (;;) {
        const bool has_next = S.next(ui + 1, nxt);
        const char* nA = (has_next && !GATHER) ? (const char*)g.A + (size_t)nxt.pm * tstep : cA; const char* nB = has_next ? (const char*)g.Bt + (size_t)nxt.pn * tstep : cB;
        for (int t = 0; t < nt; t += 2) {
            const bool last = (t == nt - 2);
            const size_t ka1 = (size_t)(t + 1) * kstep;
            const size_t ka2 = last ? (size_t)0 : (size_t)(t + 2) * kstep; const size_t ka3 = ka2 + kstep;
            const char* a2 = last ? nA : cA;
            const char* b2 = last ? nB : cB + (size_t)(t + 2) * kstep; const char* b3 = b2 + kstep;
            unsigned gN[2][2] = {{0u, 0u}, {0u, 0u}};
            if constexpr (GATHER) { if (last && has_next) {
#pragma unroll
                for (int h = 0; h < 2; ++h)
#pragma unroll
                    for (int i = 0; i < 2; ++i) gN[h][i] = S.row_off(nxt, h * HALF + Rr[i]) + (unsigned)Cc * 2u; } }
            PG8_LDB(B0, 0, 0); PG8_LDB(B1, 0, 1); PG8_SCHED; PG8_LDA(At, 0, 0); PG8_STAGE_A(PG8_SA(1, 1), cA, ka1, 1);
            PG8_WAIT_V(8); PG8_WAIT_L(0); PG8_BAR; PG8_MMA(0, 0, At, B0); PG8_MMA(0, 1, At, B1); PG8_BAR; PG8_SCHED;
            if constexpr (GATHER) { if (last && has_next) {
#pragma unroll
                for (int h = 0; h < 2; ++h)
#pragma unroll
                    for (int i = 0; i < 2; ++i) gA[h][i] = gN[h][i]; } }
            PG8_LDA(At, 0, 1); PG8_STAGE(PG8_SB(0, 0), b2, voffB); PG8_STAGE(PG8_SB(0, 1), b2 + hstepB, voffB); PG8_STAGE_A(PG8_SA(0, 0), a2, ka2, 0);
            PG8_WAIT_V(8); PG8_WAIT_L(0); PG8_BAR; PG8_MMA(1, 0, At, B0); PG8_MMA(1, 1, At, B1); PG8_BAR; PG8_SCHED;
            PG8_LDB(B0, 1, 0); PG8_LDB(B1, 1, 1); PG8_SCHED; PG8_LDA(At, 1, 0); PG8_STAGE_A(PG8_SA(0, 1), a2, ka2, 1);
            PG8_WAIT_V(8); PG8_WAIT_L(0); PG8_BAR; PG8_MMA(0, 0, At, B0); PG8_MMA(0, 1, At, B1); PG8_BAR; PG8_SCHED;
            PG8_LDA(At, 1, 1); PG8_STAGE(PG8_SB(1, 0), b3, voffB); PG8_STAGE(PG8_SB(1, 1), b3 + hstepB, voffB); PG8_STAGE_A(PG8_SA(1, 0), a2, ka3, 0);
            PG8_WAIT_V(8); PG8_WAIT_L(0); PG8_BAR; PG8_MMA(1, 0, At, B0); PG8_MMA(1, 1, At, B1); PG8_BAR; PG8_SCHED;
        }
        if constexpr (ALIGN_EPI) { if (wr == 0) PG8_BAR; }
        E(acc, cur, wr, wc, fr, fq);
        if (!has_next) break;
#pragma unroll
        for (int a = 0; a < 2; ++a)
#pragma unroll
            for (int b = 0; b < 2; ++b)
#pragma unroll
                for (int m = 0; m < 4; ++m)
#pragma unroll
                    for (int n = 0; n < 2; ++n) acc[a][b][m][n] = (f32x4){0.f, 0.f, 0.f, 0.f};
        cur = nxt; cA = nA; cB = nB; ++ui;
        if constexpr (ALIGN_EPI) { if (wr == 1) PG8_BAR; }
    }
    PG8_WAIT_V(0);
    if constexpr (!ALIGN_EPI) { if (wr == 0) PG8_BAR; }
    PG8_BAR;
#undef PG8_SA
#undef PG8_SB
#undef PG8_STAGE
#undef PG8_STAGE_A
#undef PG8_LDA
#undef PG8_LDB
#undef PG8_MMA
#undef PG8_WAIT_V
#undef PG8_WAIT_L
#undef PG8_BAR
#undef PG8_SCHED
}
}

#define GAS __attribute__((address_space(1)))
#define LAS __attribute__((address_space(3)))
typedef unsigned short bf16;
typedef pg8::f32x4 f32x4;
typedef pg8::u32x4 u32x4;
typedef pg8::bf16x8 bf16x8;
typedef float f32x2 __attribute__((ext_vector_type(2)));
typedef float f32x16 __attribute__((ext_vector_type(16)));
typedef short s16x4 __attribute__((ext_vector_type(4)));
typedef unsigned u32x2 __attribute__((ext_vector_type(2)));
using pg8::cvt_pk_bf16;

__device__ __forceinline__ float bf2f(unsigned short b) { return __uint_as_float(((unsigned)b) << 16); }
__device__ __forceinline__ float bflo(unsigned w) { return __uint_as_float(w << 16); }
__device__ __forceinline__ float bfhi(unsigned w) { return __uint_as_float(w & 0xffff0000u); }
__device__ __forceinline__ float wave_sum(float v) {
#pragma unroll
    for (int o = 1; o < 64; o <<= 1) v += __shfl_xor(v, o);
    return v;
}
__device__ __forceinline__ void store8_nt(bf16* p, const float (&v)[8]) {
    u32x4 w; w.x = cvt_pk_bf16(v[0], v[1]); w.y = cvt_pk_bf16(v[2], v[3]); w.z = cvt_pk_bf16(v[4], v[5]); w.w = cvt_pk_bf16(v[6], v[7]);
    __builtin_nontemporal_store(w, (u32x4*)p);
}
__device__ __forceinline__ void store16_wt(void* p, const u32x4 v) { asm volatile("global_store_dwordx4 %0, %1, off sc0 sc1 nt\n\ts_nop 1" :: "v"(p), "v"(v) : "memory"); }
__device__ __forceinline__ void store8(bf16* p, const float (&v)[8]) {
    u32x4 w; w.x = cvt_pk_bf16(v[0], v[1]); w.y = cvt_pk_bf16(v[2], v[3]); w.z = cvt_pk_bf16(v[4], v[5]); w.w = cvt_pk_bf16(v[6], v[7]);
    *(u32x4*)p = w;
}
__device__ __forceinline__ void rope8(float (&v)[8], const f32x2* tab) {
    const f32x4 t0 = *(const f32x4*)tab, t1 = *(const f32x4*)(tab + 2);
    const float c[4] = {t0[0], t0[2], t1[0], t1[2]}, s[4] = {t0[1], t0[3], t1[1], t1[3]};
#pragma unroll
    for (int i = 0; i < 4; ++i) { const float a = v[2 * i], b = v[2 * i + 1]; v[2 * i] = a * c[i] - b * s[i]; v[2 * i + 1] = b * c[i] + a * s[i]; }
}
#define ACC8(v, A, ai, bj, m) do { const f32x4 _x0 = A[ai][bj][m][0], _x1 = A[ai][bj][m][1]; v[0] = _x0[0]; v[1] = _x0[1]; v[2] = _x0[2]; v[3] = _x0[3]; v[4] = _x1[0]; v[5] = _x1[1]; v[6] = _x1[2]; v[7] = _x1[3]; } while (0)
typedef const f32x4 (&AccRef)[2][2][4][2];

#ifndef MOE_FUSED
#define MOE_FUSED 0
#endif
constexpr size_t MiB = 1u << 20;
constexpr size_t WS_CTL = 0, CTL_ZERO_BYTES = 1 * MiB;
constexpr size_t WS_MOD = 1 * MiB;
constexpr size_t WS_ROPE64 = 1 * MiB + 512 * 1024;
constexpr size_t WS_ROPE32 = 2 * MiB;
constexpr size_t WS_LIST = 3 * MiB;
constexpr size_t WS_W8 = 8 * MiB;
constexpr size_t WS_WIN0 = 9 * MiB;
constexpr size_t WS_WUQ = 12 * MiB;
constexpr size_t WS_WUKV = 13 * MiB;
constexpr size_t WS_WOUT0 = 14 * MiB;
constexpr size_t WS_WIN1 = 16 * MiB;
constexpr size_t WS_WOUT1 = 22 * MiB;
constexpr size_t WS_HCTX = 24 * MiB;
constexpr size_t WS_WGU = 32 * MiB;
constexpr size_t WS_WD = 97 * MiB;
constexpr size_t WS_R = 130 * MiB;
constexpr size_t R_YC = WS_R;
constexpr size_t R_H = WS_R + 288 * MiB;
#if MOE_FUSED
constexpr size_t R_F = WS_R + 324 * MiB;
constexpr size_t WS_END = R_F + 36 * MiB;
#else
constexpr size_t R_F = WS_R;
constexpr size_t WS_LW = R_H + 89 * MiB;
constexpr size_t WS_END = WS_LW + 5 * MiB;
#endif
constexpr size_t R_XN = WS_R;
constexpr size_t R_CQ = WS_R + 36 * MiB;
constexpr size_t R_CKV = WS_R + 50 * MiB;
constexpr size_t R_KR = WS_R + 59 * MiB;
constexpr size_t R_QS = WS_R + 61 * MiB;
constexpr size_t R_KS = WS_R + 79 * MiB;
constexpr size_t R_VS = WS_R + 84 * MiB;
constexpr size_t R_Q = WS_R + 89 * MiB;
constexpr size_t R_KV = WS_R + 116 * MiB;
constexpr size_t R_O = WS_R + 152 * MiB;
constexpr size_t R_A1 = R_H;
constexpr size_t R_P1 = WS_R;
constexpr size_t R_OA = WS_R + 108 * MiB;
constexpr size_t R_OB = WS_R + 140 * MiB;
constexpr size_t R_O1 = WS_R + 172 * MiB;
constexpr int CW_TMO = 0, CW_CODE = 1, CW_BAR = 4096, CW_CNT = 16384;
constexpr int RING_BYTES = 131072, LDSCTL_OFF = RING_BYTES, MISC_OFF = LDSCTL_OFF + 320;
constexpr int LDS_PFX = 132096;
constexpr int LDS_CNT = 132096 + 320;
constexpr int LDS_RSTD = 133120;
constexpr int LDS_TENS = 134144 + 4096;
constexpr int LDS_BYTES = 147456;

struct Tensors {
    const float *x, *c, *ctx, *c_ctx, *w_ada, *b_ada, *g_mix, *g_ffn, *wa_in, *ga_q, *ga_kv, *wa_uq, *wa_ukv, *wa_sink, *wa_out, *wc_in,
        *lam_q1, *lam_k1, *lam_q2, *lam_k2, *gc_sub, *wc_out, *w_router, *b_router, *we_gate, *we_up, *we_down, *ws_gate, *ws_up, *ws_down, *g_final;
    float* out; unsigned char* ws;
};

struct EpiInProj0 {
    static constexpr bool PERM = true;
    bf16 *CQ, *CKV, *KR, *QS, *KS, *VS; const f32x2 *R64, *R32;
    __device__ __forceinline__ void operator()(AccRef acc, const pg8::Unit& u, int wr, int wc, int fr, int fq) const {
        { const int l_ = lane_id(); fr = l_ & 15; fq = l_ >> 4; }
        const bool lat = u.pm < NLAT / 256;
#pragma unroll
        for (int bj = 0; bj < 2; ++bj) {
            const int col0 = u.pn * 256 + bj * 128 + wc * 32 + 8 * fq;
            const int cg = __builtin_amdgcn_readfirstlane(col0 >> 5);
            if (cg >= 45) continue;
#pragma unroll
            for (int ai = 0; ai < 2; ++ai)
#pragma unroll
                for (int m = 0; m < 4; ++m) {
                    const int row = u.pm * 256 + ai * 128 + wr * 64 + m * 16 + fr; const int t = row & (SEQ - 1);
                    float v[8]; ACC8(v, acc, ai, bj, m);
                    if (cg < 12) store8(CQ + (size_t)row * 384 + col0, v);
                    else if (cg < 20) store8(CKV + (size_t)row * 256 + (col0 - 384), v);
                    else if (cg < 21) { const int c = col0 - 640; if (lat) rope8(v, R32 + t * 16 + (c >> 1)); store8(KR + (size_t)row * 32 + c, v); }
                    else if (cg < 37) { const int c = col0 - 672; if (lat) rope8(v, R64 + t * 32 + ((c & 63) >> 1)); store8(QS + (size_t)row * 512 + c, v); }
                    else if (cg < 41) { const int c = col0 - 1184; if (lat) rope8(v, R64 + t * 32 + ((c & 63) >> 1)); store8(KS + (size_t)row * 128 + c, v); }
                    else { const int c = col0 - 1312; store8(VS + (size_t)row * 128 + c, v); }
                }
        }
    }
};
struct EpiUp {
    static constexpr bool PERM = true;
    bf16* O; const LAS float* rstd; const f32x2* R32; int LDC; bool ISQ;
    __device__ __forceinline__ void operator()(AccRef acc, const pg8::Unit& u, int wr, int wc, int fr, int fq) const {
        { const int l_ = lane_id(); fr = l_ & 15; fq = l_ >> 4; }
        const bool lat = u.pm < NLAT / 256;
#pragma unroll
        for (int bj = 0; bj < 2; ++bj) {
            const int col0 = u.pn * 256 + bj * 128 + wc * 32 + 8 * fq;
            const int cg = __builtin_amdgcn_readfirstlane(col0 >> 5);
            const bool rp = ISQ && lat && (cg % 3 == 2);
#pragma unroll
            for (int ai = 0; ai < 2; ++ai)
#pragma unroll
                for (int m = 0; m < 4; ++m) {
                    const int rl = ai * 128 + wr * 64 + m * 16 + fr; const int row = u.pm * 256 + rl; const int t = row & (SEQ - 1);
                    const float rs = rstd[(u.r & 3) * 256 + rl];
                    float v[8]; ACC8(v, acc, ai, bj, m);
#pragma unroll
                    for (int i = 0; i < 8; ++i) v[i] *= rs;
                    if (rp) rope8(v, R32 + t * 16 + ((col0 & 31) >> 1));
                    store8(O + (size_t)row * LDC + col0, v);
                }
        }
    }
};
struct EpiOutProj {
    static constexpr bool PERM = false;
    const float* hlat_old; const float* hctx_old; float* hlat; float* hctx; const float* mod;
    __device__ __forceinline__ void operator()(AccRef acc, const pg8::Unit& u, int wr, int wc, int fr, int fq) const {
        { const int l_ = lane_id(); fr = l_ & 15; fq = l_ >> 4; }
        const bool lat = u.pm < NLAT / 256;
        const int mr = lat ? (u.pm >> 3) : 8;
        const float* gate = mod + mr * 6144 + 2048;
#pragma unroll
        for (int bj = 0; bj < 2; ++bj)
#pragma unroll
            for (int n = 0; n < 2; ++n) {
                const int col = u.pn * 256 + bj * 128 + wc * 32 + 16 * n + 4 * fq;
                const f32x4 gt = *(const f32x4*)(gate + col);
#pragma unroll
                for (int ai = 0; ai < 2; ++ai)
#pragma unroll
                    for (int m = 0; m < 4; ++m) {
                        const int row = u.pm * 256 + ai * 128 + wr * 64 + m * 16 + fr;
                        const size_t off = lat ? (size_t)row * DM + col : (size_t)(row - NLAT) * DM + col;
                        const f32x4 ho = *(const f32x4*)((lat ? hlat_old : hctx_old) + off);
                        *(f32x4*)((lat ? hlat : hctx) + off) = ho + gt * acc[ai][bj][m][n];
                    }
            }
    }
};
struct EpiInProj1 {
    static constexpr bool PERM = true;
    bf16* P1; const f32x2* R64;
    __device__ __forceinline__ void operator()(AccRef acc, const pg8::Unit& u, int wr, int wc, int fr, int fq) const {
        { const int l_ = lane_id(); fr = l_ & 15; fq = l_ >> 4; }
        const bool lat = u.pm < NLAT / 256;
#pragma unroll
        for (int bj = 0; bj < 2; ++bj) {
            const int col0 = u.pn * 256 + bj * 128 + wc * 32 + 8 * fq;
            const int cg = __builtin_amdgcn_readfirstlane(col0 >> 5);
            const bool rp = lat && ((cg % 12) < 8);
#pragma unroll
            for (int ai = 0; ai < 2; ++ai)
#pragma unroll
                for (int m = 0; m < 4; ++m) {
                    const int row = u.pm * 256 + ai * 128 + wr * 64 + m * 16 + fr; const int t = row & (SEQ - 1);
                    float v[8]; ACC8(v, acc, ai, bj, m);
                    if (rp) rope8(v, R64 + t * 32 + ((col0 & 63) >> 1));
                    store8(P1 + (size_t)row * 3072 + col0, v);
                }
        }
    }
};
struct EpiGemm1 {
    static constexpr bool PERM = true;
    bf16* H;
    __device__ __forceinline__ void operator()(AccRef acc, const pg8::Unit& u, int wr, int wc, int fr, int fq) const {
        { const int l_ = lane_id(); fr = l_ & 15; fq = l_ >> 4; }
        const int pnl = u.pn & 1;
#pragma unroll
        for (int bj = 0; bj < 2; ++bj) {
            const int hc = pnl * 128 + bj * 64 + wc * 16 + 4 * fq;
#pragma unroll
            for (int ai = 0; ai < 2; ++ai)
#pragma unroll
                for (int m = 0; m < 4; ++m) {
                    const int row = u.pm * 256 + ai * 128 + wr * 64 + m * 16 + fr;
                    float v[8]; ACC8(v, acc, ai, bj, m); float h[4];
#pragma unroll
                    for (int i = 0; i < 4; ++i) { const float gg = v[2 * i]; h[i] = gg * __builtin_amdgcn_rcpf(1.f + __expf(-gg)) * v[2 * i + 1]; }
                    u32x2 w; w.x = cvt_pk_bf16(h[0], h[1]); w.y = cvt_pk_bf16(h[2], h[3]);
                    *(u32x2*)(H + (size_t)row * FF + hc) = w;
                }
        }
    }
};
struct EpiGemm2 {
    static constexpr bool PERM = true, WIDE = true;
    bf16* Yc; const int* list; const float* w8; const LAS int* cnt; float* hlat; float* hctx; const float* mod; bool dry; bf16* Hdbg;
    __device__ __forceinline__ void operator()(AccRef acc, const pg8::Unit& u, int wr, int wc, int fr, int fq) const {
        { const int l_ = lane_id(); fr = l_ & 15; fq = l_ >> 4; }
        const int pnl = u.pn & 3;
        if (u.e < NEXP) {
            const int n = cnt[u.e];
            int dest[8]; float wv[8];
#pragma unroll
            for (int q = 0; q < 8; ++q) { const int idx = u.r * 256 + (q >> 2) * 128 + wr * 64 + (q & 3) * 16 + fr; const bool ok = idx < n;
                dest[q] = ok ? list[(size_t)u.e * NT + idx] : -1; wv[q] = ok ? w8[(size_t)u.e * NT + idx] : 0.f; }
            const bool hiF = (fr & 8) != 0; const int coff = pnl * 256 + wc * 64 + 8 * fq + (hiF ? 32 : 0);
#pragma unroll
            for (int q = 0; q < 8; ++q) {
                const int ai = q >> 2, m = q & 3; const float w = wv[q];
                float va[8], vb[8]; ACC8(va, acc, ai, 0, m); ACC8(vb, acc, ai, 1, m);
                u32x4 A, B;
                A.x = cvt_pk_bf16(va[0] * w, va[1] * w); A.y = cvt_pk_bf16(va[2] * w, va[3] * w); A.z = cvt_pk_bf16(va[4] * w, va[5] * w); A.w = cvt_pk_bf16(va[6] * w, va[7] * w);
                B.x = cvt_pk_bf16(vb[0] * w, vb[1] * w); B.y = cvt_pk_bf16(vb[2] * w, vb[3] * w); B.z = cvt_pk_bf16(vb[4] * w, vb[5] * w); B.w = cvt_pk_bf16(vb[6] * w, vb[7] * w);
                const u32x4 snd = hiF ? A : B;
                u32x4 rcv; rcv.x = __shfl_xor(snd.x, 8); rcv.y = __shfl_xor(snd.y, 8); rcv.z = __shfl_xor(snd.z, 8); rcv.w = __shfl_xor(snd.w, 8);
                const int dpart = __shfl_xor(dest[q], 8);
                const int d1 = hiF ? dpart : dest[q], d2 = hiF ? dest[q] : dpart;
                const u32x4 x1 = hiF ? rcv : A, x2 = hiF ? B : rcv;
                if (d1 >= 0 && !(dry && (RDS & 16))) store16_wt(Yc + (size_t)d1 * DM + coff, x1);
                if (d2 >= 0 && !(dry && (RDS & 16))) store16_wt(Yc + (size_t)d2 * DM + coff, x2);
            }
        } else if (!dry) {
#pragma unroll
            for (int ai = 0; ai < 2; ++ai)
#pragma unroll
                for (int m = 0; m < 4; ++m) {
                    const int tok = u.r * 256 + ai * 128 + wr * 64 + m * 16 + fr;
                    const bool lat = tok < NLAT; const int mr = lat ? (tok >> 11) : 8;
                    float* hr = lat ? hlat + (size_t)tok * DM : hctx + (size_t)(tok - NLAT) * DM;
#pragma unroll
                    for (int bj = 0; bj < 2; ++bj) {
                        const int col = pnl * 256 + wc * 64 + bj * 32 + 8 * fq;
                        const float* gp = mod + mr * 6144 + 5120 + col;
#pragma unroll
                        for (int n = 0; n < 2; ++n) { const f32x4 gt = *(const f32x4*)(gp + 4 * n); f32x4 hv = *(f32x4*)(hr + col + 4 * n); hv = hv + gt * acc[ai][bj][m][n]; *(f32x4*)(hr + col + 4 * n) = hv; }
                    }
                }
        }
    }
};
struct SchedMoe {
    const LAS int* pfx; const LAS int* cnt; const int* list; int NPN, G, c; int oneT;
    __device__ __forceinline__ bool next(int i, pg8::Unit& u) const {
        const int total = pfx[65]; int T, pnl;
        if (oneT >= 0) { if (i >= NPN) return false; T = oneT; pnl = i; }
        else if (false && (G & 7) == 0 && ((G >> 3) % NPN) == 0) {
            const int x = c & 7, j = c >> 3, Gx = G >> 3, Tc = (total + 7) >> 3, Lx = i * Gx + j, Tl = Lx / NPN;
            pnl = Lx % NPN; T = x * Tc + Tl; if (Tl >= Tc || T >= total) return false;
        } else { const int L = i * G + c; if (L >= total * NPN) return false; T = L / NPN; pnl = L % NPN; }
        int lo = 0, hi = 64;
        while (lo < hi) { const int mid = (lo + hi + 1) >> 1; if (pfx[mid] <= T) lo = mid; else hi = mid - 1; }
        u.e = lo; u.r = T - pfx[lo]; u.pm = oneT >= 0 ? c : T; u.pn = lo * NPN + pnl; return true;
    }
    __device__ __forceinline__ unsigned row_off(const pg8::Unit& u, int row) const {
        int tok;
        if (u.e >= NEXP) tok = u.r * 256 + row;
        else { const int n = cnt[u.e]; int idx = u.r * 256 + row; idx = idx < n ? idx : n - 1; tok = list[(size_t)u.e * NT + idx] >> 3; }
        return (unsigned)tok * (unsigned)(DM * 2);
    }
};

namespace att {
struct Unit {
    const bf16* Q; int ldq;
    const bf16* K1; int ldk1;
    const bf16* K2; int ldk2;
    const bf16* V; int ldv;
    bf16* O; int ldo;
    int seg0_row, seg0_tiles, seg1_row, seg1_tiles;
    int qpos0, seg1_pos0;
    float sink;
};
__device__ __forceinline__ int crow(int r, int hi) { return (r & 3) + 8 * (r >> 2) + 4 * hi; }
typedef short v4i16_t __attribute__((ext_vector_type(4)));
__device__ __forceinline__ s16x4 vtr(const LAS unsigned char* p) { return __builtin_bit_cast(s16x4, __builtin_amdgcn_ds_read_tr16_b64_v4i16((LAS v4i16_t*)p)); }

#define ATT_SBAR() __builtin_amdgcn_sched_barrier(0)
constexpr float ATT_THR = 8.f;
template <bool MASK>
__device__ __forceinline__ void partialSM(f32x16& p0, f32x16& p1, float& m_reg, float& alpha, const float C, const float thr_raw, const bool domask, const int kbase, const int hi) {
    if (MASK) { if (domask) {
#pragma unroll
        for (int r = 0; r < 16; ++r) { const int d0 = kbase + crow(r, hi), d1 = d0 + 32;
            if (d0 > 128 || d0 < -128) p0[r] = -1e30f; if (d1 > 128 || d1 < -128) p1[r] = -1e30f; } } }
    float pmax = p0[0];
#pragma unroll
    for (int r = 1; r < 16; ++r) pmax = fmaxf(pmax, p0[r]);
#pragma unroll
    for (int r = 0; r < 16; ++r) pmax = fmaxf(pmax, p1[r]);
    { auto rr = __builtin_amdgcn_permlane32_swap(__float_as_uint(pmax), __float_as_uint(pmax), false, false); pmax = fmaxf(__uint_as_float(rr[0]), __uint_as_float(rr[1])); }
    float mn;
    if (__builtin_expect(__all(pmax - m_reg <= thr_raw), 1)) { mn = m_reg; alpha = 1.f; }
    else { mn = fmaxf(m_reg, pmax); alpha = __builtin_amdgcn_exp2f((m_reg - mn) * C); m_reg = mn; }
    const float mnC = -mn * C;
#pragma unroll
    for (int r = 0; r < 16; ++r) { p0[r] = fmaf(p0[r], C, mnC); p1[r] = fmaf(p1[r], C, mnC); }
#pragma unroll
    for (int r = 0; r < 16; ++r) p0[r] = __builtin_amdgcn_exp2f(p0[r]);
}
__device__ __forceinline__ void finishSM(f32x16& p0, f32x16& p1, const float alpha, float& l_reg, u32x4 (&pw)[4]) {
#pragma unroll
    for (int r = 0; r < 16; ++r) p1[r] = __builtin_amdgcn_exp2f(p1[r]);
    float ps = 0.f;
#pragma unroll
    for (int r = 0; r < 16; ++r) ps += p0[r] + p1[r];
    { auto rr = __builtin_amdgcn_permlane32_swap(__float_as_uint(ps), __float_as_uint(ps), false, false); ps = __uint_as_float(rr[0]) + __uint_as_float(rr[1]); }
    l_reg = l_reg * alpha + ps;
#pragma unroll
    for (int s = 0; s < 2; ++s) {
        pw[s] = (u32x4){cvt_pk_bf16(p0[8 * s], p0[8 * s + 1]), cvt_pk_bf16(p0[8 * s + 2], p0[8 * s + 3]), cvt_pk_bf16(p0[8 * s + 4], p0[8 * s + 5]), cvt_pk_bf16(p0[8 * s + 6], p0[8 * s + 7])};
        pw[2 + s] = (u32x4){cvt_pk_bf16(p1[8 * s], p1[8 * s + 1]), cvt_pk_bf16(p1[8 * s + 2], p1[8 * s + 3]), cvt_pk_bf16(p1[8 * s + 4], p1[8 * s + 5]), cvt_pk_bf16(p1[8 * s + 6], p1[8 * s + 7])};
    }
}
template <int DQK, int NC1, int DV, bool MASK, bool SINK>
__device__ __forceinline__ void unit(const Unit& u, const float scale, LAS unsigned char* lds, const int wid) {
    constexpr int NCH = DQK / 8, NVC = DV / 8, NQ = DQK / 16, ND = DV / 32;
    constexpr int KBYTES = NCH * 1040, VBYTES = ND * 4096;
    constexpr int KPT = (64 * NCH + 511) / 512, VPT = (64 * NVC) / 512;
    constexpr int V_OFF = 2 * KBYTES, WS_OFF = V_OFF + 3 * VBYTES;
    const int lane = lane_id(), tid = wid * 64 + lane, r32 = lane & 31, hi = lane >> 5;
    LAS float* wsf = (LAS float*)(lds + WS_OFF) + wid * 64;
    const float C = scale * 1.4426950408889634f; const float thr_raw = ATT_THR / scale;
    bf16x8 qr[NQ];
    { const bf16* qp = u.Q + (size_t)(wid * 32 + r32) * u.ldq + hi * 8;
#pragma unroll
      for (int c = 0; c < NQ; ++c) qr[c] = *(const bf16x8*)(qp + c * 16); }
    float m_reg = SINK ? u.sink / scale : -1e30f, l_reg = SINK ? 1.f : 0.f;
    f32x16 o[ND];
#pragma unroll
    for (int d = 0; d < ND; ++d) o[d] = (f32x16){};
    int kkey[KPT], kch[KPT]; bool kact[KPT]; int vkey[VPT], vch[VPT];
#pragma unroll
    for (int i = 0; i < KPT; ++i) { const int q = tid + 512 * i; kact[i] = q < 64 * NCH; const int qq = kact[i] ? q : 0; kkey[i] = qq / NCH; kch[i] = qq % NCH; }
#pragma unroll
    for (int i = 0; i < VPT; ++i) { const int q = tid + 512 * i; vkey[i] = q / NVC; vch[i] = q % NVC; }
    u32x4 ks[KPT], vs[VPT];
    const int NTILES = u.seg0_tiles + u.seg1_tiles;
#define ATT_KROW(j) ((j) < u.seg0_tiles ? u.seg0_row + 64 * (j) : u.seg1_row + 64 * ((j) - u.seg0_tiles))
#define ATT_GLOAD(j) do { const int kr0_ = ATT_KROW(j); \
      _Pragma("unroll") for (int i_ = 0; i_ < KPT; ++i_) { if (kact[i_]) { const size_t row_ = (size_t)(kr0_ + kkey[i_]); \
          const bf16* src_ = (kch[i_] < NC1) ? u.K1 + row_ * u.ldk1 + kch[i_] * 8 : u.K2 + row_ * u.ldk2 + (kch[i_] - NC1) * 8; ks[i_] = *(const u32x4*)src_; } } \
      _Pragma("unroll") for (int i_ = 0; i_ < VPT; ++i_) { vs[i_] = *(const u32x4*)(u.V + (size_t)(kr0_ + vkey[i_]) * u.ldv + vch[i_] * 8); } } while (0)
#define ATT_SWRITE(kb_i, vb_i) do { LAS unsigned char* kb_ = lds + (kb_i) * KBYTES; LAS unsigned char* vb_ = lds + V_OFF + (vb_i) * VBYTES; \
      _Pragma("unroll") for (int i_ = 0; i_ < KPT; ++i_) { if (kact[i_]) *(LAS u32x4*)(kb_ + kch[i_] * 1040 + kkey[i_] * 16) = ks[i_]; } \
      _Pragma("unroll") for (int i_ = 0; i_ < VPT; ++i_) { *(LAS u32x4*)(vb_ + (vch[i_] >> 2) * 4096 + vkey[i_] * 64 + (vch[i_] & 3) * 16) = vs[i_]; } } while (0)
#define ATT_QKT(P0, P1, kb_i) do { const LAS unsigned char* kq_ = lds + (kb_i) * KBYTES + koff; P0 = (f32x16){}; P1 = (f32x16){}; \
      _Pragma("unroll") for (int c_ = 0; c_ < NQ; ++c_) { const bf16x8 k0_ = *(const LAS bf16x8*)(kq_ + c_ * 2080), k1_ = *(const LAS bf16x8*)(kq_ + c_ * 2080 + 512); \
          P0 = __builtin_amdgcn_mfma_f32_32x32x16_bf16(k0_, qr[c_], P0, 0, 0, 0); P1 = __builtin_amdgcn_mfma_f32_32x32x16_bf16(k1_, qr[c_], P1, 0, 0, 0); } } while (0)
#define ATT_PV(vb_i) do { const LAS unsigned char* vp_ = lds + V_OFF + (vb_i) * VBYTES + voff; \
      _Pragma("unroll") for (int d_ = 0; d_ < ND; ++d_) _Pragma("unroll") for (int s_ = 0; s_ < 4; ++s_) { \
          const s16x4 lo_ = vtr(vp_ + d_ * 4096 + s_ * 1024), hh_ = vtr(vp_ + d_ * 4096 + s_ * 1024 + 512); \
          const bf16x8 vf_ = (bf16x8){lo_[0], lo_[1], lo_[2], lo_[3], hh_[0], hh_[1], hh_[2], hh_[3]}; \
          o[d_] = __builtin_amdgcn_mfma_f32_32x32x16_bf16(__builtin_bit_cast(bf16x8, pw[s_]), vf_, o[d_], 0, 0, 0); } } while (0)
#define ATT_RESC(al) do { if (__any((al) < 1.f)) { if (hi == 0) wsf[r32] = (al); asm volatile("s_waitcnt lgkmcnt(0)" ::: "memory"); \
      _Pragma("unroll") for (int r_ = 0; r_ < 16; ++r_) { const float a_ = wsf[crow(r_, hi)]; _Pragma("unroll") for (int d_ = 0; d_ < ND; ++d_) o[d_][r_] *= a_; } } } while (0)
#define ATT_MASKARGS(j) (MASK && (j) >= u.seg0_tiles), (u.seg1_pos0 + 64 * ((j) - u.seg0_tiles) - (u.qpos0 + wid * 32 + r32)), hi
    const int koff = hi * 1040 + r32 * 16;
    const int voff = ((lane >> 4) & 1) * 32 + (lane & 3) * 8 + (4 * hi + ((lane & 15) >> 2)) * 64;
    ATT_GLOAD(0); ATT_SWRITE(0, 0);
    if (1 < NTILES) { ATT_GLOAD(1); ATT_SWRITE(1, 1); }
    __syncthreads();
    f32x16 pA0, pA1, pB0, pB1; float alA, alB = 1.f; u32x4 pw[4];
    ATT_QKT(pA0, pA1, 0); partialSM<MASK>(pA0, pA1, m_reg, alA, C, thr_raw, ATT_MASKARGS(0));
    ATT_RESC(alA);
    __syncthreads();
    int vcur = 0;
#define ATT_STEP(j, C0, C1, alC, N0, N1, alN) do { const int j_ = (j); const bool hasN_ = j_ + 1 < NTILES, has2_ = j_ + 2 < NTILES; \
      ATT_SBAR(); if (hasN_) ATT_QKT(N0, N1, (j_ + 1) & 1); finishSM(C0, C1, alC, l_reg, pw); ATT_SBAR(); \
      if (has2_) ATT_GLOAD(j_ + 2); ATT_SBAR(); \
      ATT_PV(vcur); if (hasN_) partialSM<MASK>(N0, N1, m_reg, alN, C, thr_raw, ATT_MASKARGS(j_ + 1)); \
      const int v2_ = vcur == 0 ? 2 : vcur - 1;          \
      if (has2_) ATT_SWRITE(j_ & 1, v2_); \
      if (hasN_) ATT_RESC(alN); \
      __syncthreads(); vcur = vcur == 2 ? 0 : vcur + 1; } while (0)
    for (int j = 0; j < NTILES; j += 2) {
        ATT_STEP(j, pA0, pA1, alA, pB0, pB1, alB);
        if (j + 1 < NTILES) ATT_STEP(j + 1, pB0, pB1, alB, pA0, pA1, alA);
    }
    if (hi == 0) wsf[32 + r32] = l_reg;
    asm volatile("s_waitcnt lgkmcnt(0)" ::: "memory");
    bf16* Ow = u.O + (size_t)(wid * 32) * u.ldo;
#pragma unroll
    for (int r = 0; r < 16; ++r) { const int orow = crow(r, hi); const float rl = __builtin_amdgcn_rcpf(wsf[32 + orow]);
#pragma unroll
        for (int d = 0; d < ND; ++d) { const float v = o[d][r] * rl; Ow[(size_t)orow * u.ldo + d * 32 + r32] = (bf16)(cvt_pk_bf16(v, v) & 0xffffu); } }
    __syncthreads();
#undef ATT_KROW
#undef ATT_GLOAD
#undef ATT_SWRITE
#undef ATT_QKT
#undef ATT_PV
#undef ATT_RESC
#undef ATT_MASKARGS
#undef ATT_STEP
}

struct UnitD { const bf16* P; int ldp; int qcol, kcol, vcol; bf16* O; int ldo; int qrow0; int seg0_row, seg0_tiles, seg1_row, seg1_tiles; float lam, post; const float* gsub; };
__device__ __forceinline__ void unit_diff(const UnitD& u, const float scale, LAS unsigned char* lds, const int wid) {
    constexpr int NQ = 4, ND = 4, KBYTES = 8 * 1040, VBYTES = 4 * 4096;
    constexpr int V_OFF = 4 * KBYTES, WS_OFF = V_OFF + 3 * VBYTES;
    const int lane = lane_id(), tid = wid * 64 + lane, r32 = lane & 31, hi = lane >> 5; const int wsel = wid >> 2, wq = wid & 3;
    LAS float* wsf = (LAS float*)(lds + WS_OFF) + wid * 64;
    const float C = scale * 1.4426950408889634f; const float thr_raw = ATT_THR / scale;
    bf16x8 qr[NQ];
    { const bf16* qp = u.P + (size_t)(u.qrow0 + wq * 32 + r32) * u.ldp + u.qcol + wsel * 64 + hi * 8;
#pragma unroll
      for (int c = 0; c < NQ; ++c) qr[c] = *(const bf16x8*)(qp + c * 16); }
    float m_reg = -1e30f, l_reg = 0.f;
    f32x16 o[ND];
#pragma unroll
    for (int d = 0; d < ND; ++d) o[d] = (f32x16){};
    u32x4 ks[2], vs[2];
    const int NTILES = u.seg0_tiles + u.seg1_tiles;
#define ATD_KROW(j) ((j) < u.seg0_tiles ? u.seg0_row + 64 * (j) : u.seg1_row + 64 * ((j) - u.seg0_tiles))
#define ATD_GLOAD(j) do { const int kr0_ = ATD_KROW(j); \
      _Pragma("unroll") for (int i_ = 0; i_ < 2; ++i_) { const int q_ = tid + 512 * i_; \
          ks[i_] = *(const u32x4*)(u.P + (size_t)(kr0_ + ((q_ >> 3) & 63)) * u.ldp + u.kcol + (q_ >> 9) * 64 + (q_ & 7) * 8); \
          vs[i_] = *(const u32x4*)(u.P + (size_t)(kr0_ + (q_ >> 4)) * u.ldp + u.vcol + (q_ & 15) * 8); } } while (0)
#define ATD_SWRITE(kb_i, vb_i) do { LAS unsigned char* kb_ = lds + (kb_i) * 2 * KBYTES; LAS unsigned char* vb_ = lds + V_OFF + (vb_i) * VBYTES; \
      _Pragma("unroll") for (int i_ = 0; i_ < 2; ++i_) { const int q_ = tid + 512 * i_; \
          *(LAS u32x4*)(kb_ + (q_ >> 9) * KBYTES + (q_ & 7) * 1040 + ((q_ >> 3) & 63) * 16) = ks[i_]; \
          *(LAS u32x4*)(vb_ + ((q_ & 15) >> 2) * 4096 + (q_ >> 4) * 64 + (q_ & 3) * 16) = vs[i_]; } } while (0)
#define ATD_QKT(P0, P1, kb_i) do { const LAS unsigned char* kq_ = lds + ((kb_i) * 2 + wsel) * KBYTES + koff; P0 = (f32x16){}; P1 = (f32x16){}; \
      _Pragma("unroll") for (int c_ = 0; c_ < NQ; ++c_) { const bf16x8 k0_ = *(const LAS bf16x8*)(kq_ + c_ * 2080), k1_ = *(const LAS bf16x8*)(kq_ + c_ * 2080 + 512); \
          P0 = __builtin_amdgcn_mfma_f32_32x32x16_bf16(k0_, qr[c_], P0, 0, 0, 0); P1 = __builtin_amdgcn_mfma_f32_32x32x16_bf16(k1_, qr[c_], P1, 0, 0, 0); } } while (0)
#define ATD_PV(vb_i) do { const LAS unsigned char* vp_ = lds + V_OFF + (vb_i) * VBYTES + voff; \
      _Pragma("unroll") for (int d_ = 0; d_ < ND; ++d_) _Pragma("unroll") for (int s_ = 0; s_ < 4; ++s_) { \
          const s16x4 lo_ = vtr(vp_ + d_ * 4096 + s_ * 1024), hh_ = vtr(vp_ + d_ * 4096 + s_ * 1024 + 512); \
          const bf16x8 vf_ = (bf16x8){lo_[0], lo_[1], lo_[2], lo_[3], hh_[0], hh_[1], hh_[2], hh_[3]}; \
          o[d_] = __builtin_amdgcn_mfma_f32_32x32x16_bf16(__builtin_bit_cast(bf16x8, pw[s_]), vf_, o[d_], 0, 0, 0); } } while (0)
#define ATD_RESC(al) do { if (__any((al) < 1.f)) { if (hi == 0) wsf[r32] = (al); asm volatile("s_waitcnt lgkmcnt(0)" ::: "memory"); \
      _Pragma("unroll") for (int r_ = 0; r_ < 16; ++r_) { const float a_ = wsf[crow(r_, hi)]; _Pragma("unroll") for (int d_ = 0; d_ < ND; ++d_) o[d_][r_] *= a_; } } } while (0)
    const int koff = hi * 1040 + r32 * 16;
    const int voff = ((lane >> 4) & 1) * 32 + (lane & 3) * 8 + (4 * hi + ((lane & 15) >> 2)) * 64;
    ATD_GLOAD(0); ATD_SWRITE(0, 0);
    if (1 < NTILES) { ATD_GLOAD(1); ATD_SWRITE(1, 1); }
    __syncthreads();
    f32x16 pA0, pA1, pB0, pB1; float alA, alB = 1.f; u32x4 pw[4];
    ATD_QKT(pA0, pA1, 0); partialSM<false>(pA0, pA1, m_reg, alA, C, thr_raw, false, 0, hi);
    ATD_RESC(alA);
    __syncthreads();
    int vcur = 0;
#define ATD_STEP(j, C0, C1, alC, N0, N1, alN) do { const int j_ = (j); const bool hasN_ = j_ + 1 < NTILES, has2_ = j_ + 2 < NTILES; \
      ATT_SBAR(); if (hasN_) ATD_QKT(N0, N1, (j_ + 1) & 1); finishSM(C0, C1, alC, l_reg, pw); ATT_SBAR(); \
      if (has2_) ATD_GLOAD(j_ + 2); ATT_SBAR(); \
      ATD_PV(vcur); if (hasN_) partialSM<false>(N0, N1, m_reg, alN, C, thr_raw, false, 0, hi); \
      const int v2_ = vcur == 0 ? 2 : vcur - 1; \
      if (has2_) ATD_SWRITE(j_ & 1, v2_); \
      if (hasN_) ATD_RESC(alN); \
      __syncthreads(); vcur = vcur == 2 ? 0 : vcur + 1; } while (0)
    for (int j = 0; j < NTILES; j += 2) {
        ATD_STEP(j, pA0, pA1, alA, pB0, pB1, alB);
        if (j + 1 < NTILES) ATD_STEP(j + 1, pB0, pB1, alB, pA0, pA1, alA);
    }
    if (hi == 0) wsf[32 + r32] = l_reg;
    asm volatile("s_waitcnt lgkmcnt(0)" ::: "memory");
    float rl[16];
#pragma unroll
    for (int r = 0; r < 16; ++r) rl[r] = __builtin_amdgcn_rcpf(wsf[32 + crow(r, hi)]);
    LAS float* X = (LAS float*)lds + wq * 4096;
    if (wsel == 1) {
#pragma unroll
        for (int d = 0; d < ND; ++d)
#pragma unroll
            for (int r = 0; r < 16; ++r) X[(d * 16 + r) * 64 + lane] = o[d][r] * rl[r];
    }
    __syncthreads();
    if (wsel == 0) {
        float ss[16];
#pragma unroll
        for (int r = 0; r < 16; ++r) { float s = 0.f;
#pragma unroll
            for (int d = 0; d < ND; ++d) { const float v = o[d][r] * rl[r] - u.lam * X[(d * 16 + r) * 64 + lane]; o[d][r] = v; s += v * v; }
            ss[r] = s; }
#pragma unroll
        for (int r = 0; r < 16; ++r) { float s = ss[r]; s += __shfl_xor(s, 1); s += __shfl_xor(s, 2); s += __shfl_xor(s, 4); s += __shfl_xor(s, 8); s += __shfl_xor(s, 16); ss[r] = rsqrtf(s * (1.f / 128.f) + EPS) * u.post; }
        bf16* Ow = u.O + (size_t)(u.qrow0 + wq * 32) * u.ldo;
#pragma unroll
        for (int d = 0; d < ND; ++d) { const float g = u.gsub[d * 32 + r32];
#pragma unroll
            for (int r = 0; r < 16; ++r) { const float v = o[d][r] * ss[r] * g; Ow[(size_t)crow(r, hi) * u.ldo + d * 32 + r32] = (bf16)(cvt_pk_bf16(v, v) & 0xffffu); } }
    }
    __syncthreads();
#undef ATD_KROW
#undef ATD_GLOAD
#undef ATD_SWRITE
#undef ATD_QKT
#undef ATD_PV
#undef ATD_RESC
#undef ATD_STEP
}
}

typedef GAS unsigned gu32;
#define RLX_AGENT __ATOMIC_RELAXED, __HIP_MEMORY_SCOPE_AGENT
#define LDS_WAIT() asm volatile("s_waitcnt lgkmcnt(0)" ::: "memory")
#define VM_WAIT() asm volatile("s_waitcnt vmcnt(0)" ::: "memory")
#define XB_TMO      128
#define XB_XCNT(j)  (256  + 64 * (j))
#define XB_XSUB(j)  (1280 + 64 * (j))
#define XB_XGEN(j)  (2304 + 64 * (j))
#define XB_TOP      3328
#define XB_TOPGEN   3392
#define XCD_BAR_WORDS 3456
#define XB_SPIN_CAP (1u << 18)
__device__ __forceinline__ unsigned xb_ld(unsigned* p)              { return __hip_atomic_load(p, __ATOMIC_RELAXED, __HIP_MEMORY_SCOPE_AGENT); }
__device__ __forceinline__ unsigned xb_add(unsigned* p, unsigned v) { return __hip_atomic_fetch_add(p, v, __ATOMIC_RELAXED, __HIP_MEMORY_SCOPE_AGENT); }
__device__ __forceinline__ unsigned xb_xcc_id() { return (unsigned)__builtin_amdgcn_s_getreg((3 << 11) | 20) & 0xFu; }
#define XB_SPIN(cond, bar) do { unsigned _sp = 0; while (cond) { __builtin_amdgcn_s_sleep(1); \
    if ((++_sp & 255u) == 0u) { if (xb_ld(&(bar)[XB_TMO])) break; if (_sp > XB_SPIN_CAP) { atomicAdd(&(bar)[XB_TMO], 1u); break; } } } } while (0)
struct XcdBarrier { unsigned* bar; unsigned x; volatile LAS unsigned* st; };
__device__ __forceinline__ XcdBarrier xcd_barrier_post(unsigned* bar, volatile LAS unsigned* st, const int wave) {
    XcdBarrier b; b.bar = bar; b.x = xb_xcc_id(); b.st = st;
    if (wave == 0 && lane_id() == 0) st[2] = xb_add(&bar[XB_XCNT(b.x)], 1u);
    return b;
}
__device__ __forceinline__ void xcd_barrier_complete(unsigned* bar, unsigned x, unsigned& nloc, unsigned& nx) {
    const unsigned G = gridDim.x * gridDim.y * gridDim.z;
    unsigned sum, cnt, mine, sp = 0u;
    for (;;) {
        sum = 0u; cnt = 0u; mine = 0u;
#pragma unroll
        for (unsigned j = 0; j < 16; ++j) { const unsigned c = xb_ld(&bar[XB_XCNT(j)]); sum += c; cnt += (c > 0u) ? 1u : 0u; mine = (j == x) ? c : mine; }
        if (sum == G) break;
        __builtin_amdgcn_s_sleep(1);
        if ((++sp & 255u) == 0u) { if (xb_ld(&bar[XB_TMO])) break; if (sp > XB_SPIN_CAP) { atomicAdd(&bar[XB_TMO], 1u); break; } }
    }
    nloc = mine > 0u ? mine : 1u; nx = cnt > 0u ? cnt : 1u;
}
__device__ __forceinline__ void xcd_barrier(const XcdBarrier& b, const int wave) {
    asm volatile("s_waitcnt vmcnt(0)" ::: "memory");
    __syncthreads();
    if (wave == 0 && lane_id() == 0) {
        unsigned* bar = b.bar;
        __builtin_amdgcn_s_waitcnt(0);
        unsigned nloc = b.st[0], nx = b.st[1];
        if (nloc == 0u) { xcd_barrier_complete(bar, b.x, nloc, nx); b.st[0] = nloc; b.st[1] = nx; }
        const unsigned old = xb_add(&bar[XB_XSUB(b.x)], 1u);
        const unsigned gen = old / nloc;
        if (old + 1u == (gen + 1u) * nloc) {
            __builtin_amdgcn_fence(__ATOMIC_RELEASE, "agent");
            asm volatile("s_waitcnt vmcnt(0)" ::: "memory");
            const unsigned og = xb_add(&bar[XB_TOP], 1u);
            const unsigned tg = og / nx;
            if (og + 1u == (tg + 1u) * nx) xb_add(&bar[XB_TOPGEN], 1u);
            else XB_SPIN(xb_ld(&bar[XB_TOPGEN]) == tg, bar);
            __builtin_amdgcn_fence(__ATOMIC_ACQUIRE, "agent");
            xb_add(&bar[XB_XGEN(b.x)], 1u);
            asm volatile("s_waitcnt vmcnt(0)" ::: "memory");
        } else {
            XB_SPIN(xb_ld(&bar[XB_XGEN(b.x)]) == gen, bar);
            __builtin_amdgcn_fence(__ATOMIC_ACQUIRE, "agent");
            asm volatile("s_waitcnt vmcnt(0)" ::: "memory");
        }
    }
    __syncthreads();
}

__device__ __forceinline__ void vcu_setup(const XcdBarrier& b, const int wave) {
    if (wave == 0 && lane_id() == 0) { unsigned pre = 0u;
        for (unsigned j = 0; j < 16; ++j) { const unsigned c = xb_ld(&b.bar[XB_XCNT(j)]); if (j < b.x) pre += c; }
        b.st[3] = pre + b.st[2] + 1u; }
}
struct Frame {
    LAS unsigned char* lds; volatile LAS unsigned* MISC; gu32* ctl;
    int wave, G, blk;
    const LAS Tensors* Tl; float* out; unsigned char* ws;
};
__device__ __forceinline__ const float* uni_ptr(const float* const LAS* p) { const unsigned long long v = *(const LAS unsigned long long*)p; const unsigned lo = __builtin_amdgcn_readfirstlane((unsigned)v), hi = __builtin_amdgcn_readfirstlane((unsigned)(v >> 32)); return (const float*)(((unsigned long long)hi << 32) | lo); }
#define TT(name) uni_ptr(&F.Tl->name)
#define FLANE lane_id()
#define FTID (F.wave * 64 + lane_id())
__device__ __forceinline__ float* residual_row(const Frame& F, int tok) { return tok < NLAT ? F.out + (size_t)tok * DM : (float*)(F.ws + WS_HCTX) + (size_t)(tok - NLAT) * DM; }

__device__ __forceinline__ int rot32perm(int i) { const int blk = i >> 4, w = i & 15; return blk * 16 + 2 * (w & 7) + (w >> 3); }
__device__ __forceinline__ int rot64perm(int i) { const int blk = i >> 5, w = i & 31; return blk * 32 + 2 * (w & 15) + (w >> 4); }
__device__ __forceinline__ int drow_map(int kind, int n) {
    switch (kind) {
    case 1: if (n < 640) return n; if (n < 672) return 640 + rot32perm(n - 640); if (n < 1312) { const int base = n < 1184 ? 672 : 1184; const int c = n - base; return base + (c & ~63) + rot64perm(c & 63); } return n;
    case 2: { const int h = n / 96, w = n % 96; return w < 64 ? n : h * 96 + 64 + rot32perm(w - 64); }
    case 3: { const int h = n / 384, w = n % 384; return w < 256 ? h * 384 + (w & ~63) + rot64perm(w & 63) : n; }
    case 4: return 2 * n;
    case 5: return 2 * n + 1;
    default: return n;
    }
}
struct TJob { const float* src; bf16* dst; const float* kscale; int K, N, nbatch, kind; size_t dstb; };
__device__ __forceinline__ void transpose_item(const TJob& J, int item, LAS float* scr, int lane) {
    const int nblk = (J.N + 63) / 64; const int per = (J.K / 64) * nblk; const int bidx = item / per; const int r = item % per;
    const int kb = r / nblk, nb = r % nblk, k0 = 64 * kb, n0 = 64 * nb;
    const float* W = J.src + (size_t)bidx * J.K * J.N; bf16* WT = J.dst + (size_t)bidx * J.dstb;
    const int m4 = 4 * (lane & 15), kq = lane >> 4;
    const bool nin = n0 + m4 < J.N;
    f32x4 v[16];
#pragma unroll
    for (int i = 0; i < 16; ++i) { const int k = k0 + 4 * i + kq; v[i] = nin ? __builtin_nontemporal_load((const f32x4*)(W + (size_t)k * J.N + n0 + m4)) : (f32x4){0.f, 0.f, 0.f, 0.f}; }
    if (J.kscale) {
#pragma unroll
        for (int i = 0; i < 16; ++i) v[i] = v[i] * J.kscale[k0 + 4 * i + kq]; }
#pragma unroll
    for (int i = 0; i < 16; ++i) { const int kk = 4 * i + kq; *(LAS f32x4*)(scr + kk * 64 + (m4 ^ (4 * (kk >> 3)))) = v[i]; }
    LDS_WAIT(); asm volatile("" ::: "memory");
    const int c = lane & 7, nl = lane >> 3;
#pragma unroll
    for (int j = 0; j < 8; ++j) { const int n = 8 * j + nl; const LAS float* sp = scr + (8 * c) * 64 + (n ^ (4 * c));
        u32x4 o; o.x = cvt_pk_bf16(sp[0], sp[64]); o.y = cvt_pk_bf16(sp[128], sp[192]); o.z = cvt_pk_bf16(sp[256], sp[320]); o.w = cvt_pk_bf16(sp[384], sp[448]);
        if (n0 + n < J.N) *(u32x4*)(WT + (size_t)drow_map(J.kind, n0 + n) * J.K + k0 + 8 * c) = o; }
    LDS_WAIT(); asm volatile("" ::: "memory");
}
__device__ __forceinline__ int job_items(const TJob& J) { return (J.K / 64) * ((J.N + 63) / 64) * J.nbatch; }
template <int NJ> __device__ __forceinline__ void run_jobs(const Frame& F, const TJob (&jobs)[NJ]) {
    LAS float* scr = (LAS float*)(F.lds + F.wave * 16384);
    const int gw = F.blk * 8 + F.wave, NGW = F.G * 8;
    int total = 0;
#pragma unroll
    for (int j = 0; j < NJ; ++j) total += job_items(jobs[j]);
    for (int it = gw; it < total; it += NGW) {
        int r = it;
#pragma unroll
        for (int j = 0; j < NJ; ++j) { const int n = job_items(jobs[j]); if (r >= 0 && r < n) { transpose_item(jobs[j], r, scr, FLANE); } r -= n; }
    }
}
__device__ __forceinline__ void convert_expert_weights(const Frame& F, int l) {
    unsigned char* ws = F.ws; bf16* WGU = (bf16*)(ws + WS_WGU); bf16* WD = (bf16*)(ws + WS_WD);
    const size_t eoff = (size_t)l * NEXP * DM * FF, soff = (size_t)l * DM * FF;
    const TJob jobs[6] = {
        {TT(we_gate) + eoff, WGU, nullptr, DM, FF, NEXP, 4, (size_t)512 * DM},
        {TT(we_up) + eoff, WGU, nullptr, DM, FF, NEXP, 5, (size_t)512 * DM},
        {TT(we_down) + eoff, WD, nullptr, FF, DM, NEXP, 0, (size_t)DM * FF},
        {TT(ws_gate) + soff, WGU + (size_t)NEXP * 512 * DM, nullptr, DM, FF, 1, 4, (size_t)512 * DM},
        {TT(ws_up) + soff, WGU + (size_t)NEXP * 512 * DM, nullptr, DM, FF, 1, 5, (size_t)512 * DM},
        {TT(ws_down) + soff, WD + (size_t)NEXP * DM * FF, nullptr, FF, DM, 1, 0, (size_t)DM * FF}};
    run_jobs<6>(F, jobs);
}
__device__ __forceinline__ void p0_prologue(const Frame& F) {
    unsigned char* ws = F.ws;
    if (F.blk < 96) {
        LAS float* sil = (LAS float*)(F.lds + 40960);
        for (int i = FTID; i < 9 * DM; i += 512) { const int r = i / DM, k = i % DM; const float xv = r < 8 ? TT(c)[r * DM + k] : TT(c_ctx)[k]; sil[k * 12 + r] = xv / (1.f + __expf(-xv)); }
        __syncthreads();
    }
    for (int task = F.blk; task < 96; task += F.G) {
        const int lane = FLANE; const int l = task / 48, c0 = (task % 48) * 128 + 2 * lane;
        const LAS float* sil = (const LAS float*)(F.lds + 40960);
        float a0[9], a1[9];
#pragma unroll
        for (int r = 0; r < 9; ++r) { a0[r] = 0.f; a1[r] = 0.f; }
        const float* wp = TT(w_ada) + ((size_t)l * DM + F.wave * 128) * 6144 + c0;
#pragma unroll 4
        for (int kk = 0; kk < 128; ++kk) {
            const int k = F.wave * 128 + kk; const f32x2 w2 = *(const f32x2*)(wp + (size_t)kk * 6144);
            const f32x4 s0 = *(const LAS f32x4*)(sil + k * 12), s1 = *(const LAS f32x4*)(sil + k * 12 + 4), s2 = *(const LAS f32x4*)(sil + k * 12 + 8);
            const float sv[9] = {s0[0], s0[1], s0[2], s0[3], s1[0], s1[1], s1[2], s1[3], s2[0]};
#pragma unroll
            for (int r = 0; r < 9; ++r) { a0[r] = fmaf(sv[r], w2[0], a0[r]); a1[r] = fmaf(sv[r], w2[1], a1[r]); }
        }
        LAS float* part = (LAS float*)F.lds;
#pragma unroll
        for (int r = 0; r < 9; ++r) { part[(F.wave * 9 + r) * 128 + 2 * lane] = a0[r]; part[(F.wave * 9 + r) * 128 + 2 * lane + 1] = a1[r]; }
        __syncthreads();
        float* mod = (float*)(ws + WS_MOD) + (size_t)l * 9 * 6144;
        for (int i = FTID; i < 9 * 128; i += 512) { const int r = i / 128, cc = i % 128; float s = 0.f;
#pragma unroll
            for (int w = 0; w < 8; ++w) s += part[(w * 9 + r) * 128 + cc];
            const int col = (task % 48) * 128 + cc; mod[r * 6144 + col] = s + TT(b_ada)[l * 6144 + col]; }
        __syncthreads();
    }
    { f32x2* R64 = (f32x2*)(ws + WS_ROPE64); f32x2* R32 = (f32x2*)(ws + WS_ROPE32);
      for (int i = F.blk * 512 + FTID; i < SEQ * 48; i += F.G * 512) {
          const int t = i / 48, p = i % 48; const float prow = (float)(t >> 6), pcol = (float)(t & 63);
          if (p < 32) { const int blk = p >> 4, j = p & 15; const float inv = exp2f(-(float)(2 * j) / 32.f * 13.287712379549449f); const float ang = (blk ? pcol : prow) * inv; R64[t * 32 + p] = (f32x2){cosf(ang), sinf(ang)}; }
          else { const int q = p - 32, blk = q >> 3, j = q & 7; const float inv = exp2f(-(float)(2 * j) / 16.f * 13.287712379549449f); const float ang = (blk ? pcol : prow) * inv; R32[t * 16 + q] = (f32x2){cosf(ang), sinf(ang)}; }
      } }
    { const TJob jobs[6] = {
        {TT(wa_in), (bf16*)(ws + WS_WIN0), nullptr, DM, 1440, 1, 1, 0},
        {TT(wa_uq), (bf16*)(ws + WS_WUQ), TT(ga_q), 384, 768, 1, 2, 0},
        {TT(wa_ukv), (bf16*)(ws + WS_WUKV), TT(ga_kv), 256, 1024, 1, 0, 0},
        {TT(wa_out), (bf16*)(ws + WS_WOUT0), nullptr, DM, DM, 1, 0, 0},
        {TT(wc_in), (bf16*)(ws + WS_WIN1), nullptr, DM, 3072, 1, 3, 0},
        {TT(wc_out), (bf16*)(ws + WS_WOUT1), nullptr, DM, DM, 1, 0, 0}};
      run_jobs<6>(F, jobs); }
}
__device__ __forceinline__ void normmod_row(const float* hrow, const float* g, const float* sh, const float* sc, bf16* orow, int lane) {
    f32x4 v[4]; float s = 0.f;
#pragma unroll
    for (int j = 0; j < 4; ++j) { v[j] = *(const f32x4*)(hrow + 4 * (lane + 64 * j)); s += (v[j][0] * v[j][0] + v[j][1] * v[j][1]) + (v[j][2] * v[j][2] + v[j][3] * v[j][3]); }
    const float rstd = rsqrtf(wave_sum(s) * (1.f / DM) + EPS);
#pragma unroll
    for (int j = 0; j < 4; ++j) { const int c = 4 * (lane + 64 * j); const f32x4 gv = *(const f32x4*)(g + c), shv = *(const f32x4*)(sh + c), scv = *(const f32x4*)(sc + c);
        const f32x4 y = (v[j] * rstd * gv) * (scv + 1.f) + shv;
        u32x2 w; w.x = cvt_pk_bf16(y[0], y[1]); w.y = cvt_pk_bf16(y[2], y[3]); *(u32x2*)(orow + c) = w; }
}

__device__ __forceinline__ void route_row(float logit, float bias, int lane, int& rk_out, float& w_out) {
    const float s = 1.f / (1.f + __expf(-logit));
    const float bsd = s + bias;
    int rg = 0; const int gl = lane & 7;
#pragma unroll
    for (int k = 0; k < 8; ++k) { const float v = __shfl(bsd, (lane & ~7) | k); rg += ((v > bsd) || (v == bsd && k < gl)) ? 1 : 0; }
    float gs = rg < 2 ? bsd : 0.f;
    gs += __shfl_xor(gs, 1); gs += __shfl_xor(gs, 2); gs += __shfl_xor(gs, 4);
    int rkg = 0; const int g = lane >> 3;
#pragma unroll
    for (int gg = 0; gg < 8; ++gg) { const float v = __shfl(gs, gg * 8); rkg += ((v > gs) || (v == gs && gg < g)) ? 1 : 0; }
    const float msk = rkg < 4 ? bsd : -1e30f;
    int rk = 0;
#pragma unroll 4
    for (int j = 0; j < 64; ++j) { const float v = __builtin_bit_cast(float, __builtin_amdgcn_readlane(__builtin_bit_cast(int, msk), j)); rk += ((v > msk) || (v == msk && j < lane)) ? 1 : 0; }
    const bool sel = rk < 8;
    const float ssum = wave_sum(sel ? s : 0.f);
    rk_out = sel ? rk : -1; w_out = s / ssum * 2.5f;
}
__device__ __forceinline__ void route_phase(const Frame& F, int l, int ntok, const bool dry = false) {
    unsigned char* ws = F.ws;
    LAS float* wbuf = (LAS float*)F.lds;
    LAS int* hist = (LAS int*)(F.lds + 104448); LAS int* base = hist + 64;
    const int lane = FLANE, tid = F.wave * 64 + lane;
    LAS float* fch = (LAS float*)(F.lds + 65536) + F.wave * 1152;
    LAS int* st_i = (LAS int*)(F.lds + 104960) + F.wave * 144; LAS float* st_w = (LAS float*)(st_i + 72);
    if (tid < 64) hist[tid] = 0;
    for (int i = lane; i < 72; i += 64) st_i[i] = -1;
    const int gw = F.blk * 8 + F.wave, NGW = F.G * 8;
    const float* mod = (const float*)(ws + WS_MOD) + (size_t)l * 9 * 6144;
    const float* gf = TT(g_ffn) + l * DM; const float* wr = TT(w_router) + (size_t)l * DM * NEXP; const float bias = TT(b_router)[l * NEXP + lane];
    bf16* XN = (bf16*)(ws + R_F);
    f32x4 v[9][4]; float rstd[9];
#pragma unroll
    for (int r = 0; r < 9; ++r) {
        const int tok = gw + r * NGW; float s = 0.f;
        if (tok < ntok) { const float* hrow = residual_row(F, tok);
#pragma unroll
            for (int jj = 0; jj < 4; ++jj) { v[r][jj] = *(const f32x4*)(hrow + 4 * (lane + 64 * jj)); s += (v[r][jj][0] * v[r][jj][0] + v[r][jj][1] * v[r][jj][1]) + (v[r][jj][2] * v[r][jj][2] + v[r][jj][3] * v[r][jj][3]); } }
        else {
#pragma unroll
            for (int jj = 0; jj < 4; ++jj) v[r][jj] = (f32x4){0.f, 0.f, 0.f, 0.f}; }
        rstd[r] = rsqrtf(wave_sum(s) * (1.f / DM) + EPS);
    }
    f32x2 acc2[9];
#pragma unroll
    for (int r = 0; r < 9; ++r) acc2[r] = (f32x2){0.f, 0.f};
    f32x4 wreg[4];
#pragma unroll
    for (int i = 0; i < 4; ++i) wreg[i] = *(const f32x4*)(wr + 4 * (tid + 512 * i));
#pragma unroll
    for (int ch = 0; ch < 8; ++ch) {
        LAS float* wb = wbuf + (ch & 1) * 8192;
#pragma unroll
        for (int i = 0; i < 4; ++i) *(LAS f32x4*)(wb + 4 * (tid + 512 * i)) = wreg[i];
        if (ch + 1 < 8) {
#pragma unroll
            for (int i = 0; i < 4; ++i) wreg[i] = *(const f32x4*)(wr + (ch + 1) * 8192 + 4 * (tid + 512 * i)); }
        if ((lane >> 5) == (ch & 1) && !(dry && (RDS & 2))) {
            const int cl = 4 * (lane & 31), c = 128 * ch + cl; const f32x4 gv = *(const f32x4*)(gf + c);
#pragma unroll
            for (int r = 0; r < 9; ++r) {
                const int tok = gw + r * NGW;
                if (tok < ntok) { const int mr = tok < NLAT ? (tok >> 11) : 8;
                    const f32x4 shv = *(const f32x4*)(mod + mr * 6144 + 3072 + c), scv = *(const f32x4*)(mod + mr * 6144 + 4096 + c);
                    const f32x4 y = (v[r][ch >> 1] * rstd[r] * gv) * (scv + 1.f) + shv;
                    u32x2 w; w.x = cvt_pk_bf16(y[0], y[1]); w.y = cvt_pk_bf16(y[2], y[3]); *(u32x2*)(XN + (size_t)tok * DM + c) = w;
                    *(LAS f32x4*)(fch + r * 128 + cl) = y; }
            }
        }
        __syncthreads();
        if (!(dry && (RDS & 1)))
#pragma unroll 1
        for (int c4 = 0; c4 < 32; ++c4) {
            const f32x2 w01 = (f32x2){wb[(4 * c4 + 0) * 64 + lane], wb[(4 * c4 + 1) * 64 + lane]}, w23 = (f32x2){wb[(4 * c4 + 2) * 64 + lane], wb[(4 * c4 + 3) * 64 + lane]};
            f32x4 fa[5], fb[4];
#pragma unroll
            for (int r = 0; r < 5; ++r) fa[r] = *(const LAS f32x4*)(fch + r * 128 + 4 * c4);
#pragma unroll
            for (int r = 0; r < 4; ++r) fb[r] = *(const LAS f32x4*)(fch + (5 + r) * 128 + 4 * c4);
#pragma unroll
            for (int r = 0; r < 5; ++r) { acc2[r] = (f32x2){fa[r][0], fa[r][1]} * w01 + acc2[r]; acc2[r] = (f32x2){fa[r][2], fa[r][3]} * w23 + acc2[r]; }
#pragma unroll
            for (int r = 0; r < 4; ++r) { acc2[5 + r] = (f32x2){fb[r][0], fb[r][1]} * w01 + acc2[5 + r]; acc2[5 + r] = (f32x2){fb[r][2], fb[r][3]} * w23 + acc2[5 + r]; }
        }
    }
    float acc[9];
#pragma unroll
    for (int r = 0; r < 9; ++r) acc[r] = acc2[r][0] + acc2[r][1];
#pragma unroll
    for (int r = 0; r < 9; ++r) {
        const int tok = gw + r * NGW;
        if (tok < ntok && !(dry && (RDS & 4))) {
            int rk; float w; route_row(acc[r], bias, lane, rk, w);
            if (rk >= 0 && !dry) { const int pos = atomicAdd((int*)(hist + lane), 1); st_i[r * 8 + rk] = (pos << 8) | lane; st_w[r * 8 + rk] = w; }
        }
    }
    __syncthreads();
    int* cntg = (int*)(F.ctl) + CW_CNT + l * 64;
    if (tid < 64 && !dry) base[tid] = atomicAdd(cntg + tid, hist[tid]);
    __syncthreads();
    int* list = (int*)(ws + WS_LIST); float* w8 = (float*)(ws + WS_W8);
    for (int i = lane; i < 72; i += 64) {
        const int pk = st_i[i];
        if (pk >= 0) { const int e = pk & 255, tok = gw + (i >> 3) * NGW; const int dest = tok * 8 + (i & 7); list[(size_t)e * NT + base[e] + (pk >> 8)] = dest; ((float*)(ws + WS_LW))[(size_t)e * NT + base[e] + (pk >> 8)] = st_w[i]; w8[dest] = st_w[i]; }
    }
    __syncthreads();
}
__device__ __forceinline__ void moe_setup(const Frame& F, int l, int ntok) {
    LAS int* pfx = (LAS int*)(F.lds + LDS_PFX); LAS int* cnt = (LAS int*)(F.lds + LDS_CNT);
    __syncthreads();
    if (FTID == 0) {
        const int* cntg = (const int*)(F.ctl) + CW_CNT + l * 64; int acc = 0;
        for (int e = 0; e < NEXP; ++e) { const int n = __hip_atomic_load(cntg + e, __ATOMIC_RELAXED, __HIP_MEMORY_SCOPE_AGENT); cnt[e] = n; pfx[e] = acc; acc += (n + 255) >> 8; }
        cnt[64] = ntok; pfx[64] = acc; acc += ntok >> 8; pfx[65] = acc;
    }
    __syncthreads();
}
__device__ __forceinline__ void combine_phase(const Frame& F, int l, int ntok, const bool dry = false) {
    unsigned char* ws = F.ws;
    const int gw = F.blk * 8 + F.wave, NGW = F.G * 8, lane = FLANE, c0 = 16 * lane;
    const bf16* Yc = (const bf16*)(ws + R_YC);
    const float* mod = (const float*)(ws + WS_MOD) + (size_t)l * 9 * 6144;
    for (int tok = gw; tok < ntok; tok += NGW) {
        float y[16];
#pragma unroll
        for (int i = 0; i < 16; ++i) y[i] = 0.f;
#pragma unroll
        for (int j = 0; j < 8; ++j) {
            const u32x4 a = *(const u32x4*)(Yc + ((size_t)tok * 8 + j) * DM + c0), b = *(const u32x4*)(Yc + ((size_t)tok * 8 + j) * DM + c0 + 8);
            y[0] += bflo(a.x); y[1] += bfhi(a.x); y[2] += bflo(a.y); y[3] += bfhi(a.y); y[4] += bflo(a.z); y[5] += bfhi(a.z); y[6] += bflo(a.w); y[7] += bfhi(a.w);
            y[8] += bflo(b.x); y[9] += bfhi(b.x); y[10] += bflo(b.y); y[11] += bfhi(b.y); y[12] += bflo(b.z); y[13] += bfhi(b.z); y[14] += bflo(b.w); y[15] += bfhi(b.w);
        }
        float* hrow = residual_row(F, tok); const int mr = tok < NLAT ? (tok >> 11) : 8;
        const float* gt = mod + mr * 6144 + 5120 + c0;
        f32x4 h[4]; float s = 0.f;
#pragma unroll
        for (int j = 0; j < 4; ++j) { const f32x4 hv = *(const f32x4*)(hrow + c0 + 4 * j), g4 = *(const f32x4*)(gt + 4 * j);
            h[j] = hv + g4 * (f32x4){y[4 * j], y[4 * j + 1], y[4 * j + 2], y[4 * j + 3]};
            s += (h[j][0] * h[j][0] + h[j][1] * h[j][1]) + (h[j][2] * h[j][2] + h[j][3] * h[j][3]); }
        const float rstd = rsqrtf(wave_sum(s) * (1.f / DM) + EPS);
        if (dry) { asm volatile("" :: "v"(rstd), "v"(h[0]), "v"(h[1]), "v"(h[2]), "v"(h[3])); continue; }
        if (l == 0) {
            const float* mod1 = (const float*)(ws + WS_MOD) + (size_t)9 * 6144 + mr * 6144;
            const float* g = TT(g_mix) + DM + c0; bf16* arow = (bf16*)(ws + R_A1) + (size_t)tok * DM + c0;
            float o[16];
#pragma unroll
            for (int j = 0; j < 4; ++j) { *(f32x4*)(hrow + c0 + 4 * j) = h[j];
                const f32x4 gv = *(const f32x4*)(g + 4 * j), shv = *(const f32x4*)(mod1 + c0 + 4 * j), scv = *(const f32x4*)(mod1 + 1024 + c0 + 4 * j);
                const f32x4 yv = (h[j] * rstd * gv) * (scv + 1.f) + shv; o[4 * j] = yv[0]; o[4 * j + 1] = yv[1]; o[4 * j + 2] = yv[2]; o[4 * j + 3] = yv[3]; }
            const float o0[8] = {o[0], o[1], o[2], o[3], o[4], o[5], o[6], o[7]}, o1[8] = {o[8], o[9], o[10], o[11], o[12], o[13], o[14], o[15]};
            store8(arow, o0); store8(arow + 8, o1);
        } else {
            const float* g = TT(g_final) + c0;
#pragma unroll
            for (int j = 0; j < 4; ++j) { const f32x4 gv = *(const f32x4*)(g + 4 * j); *(f32x4*)(hrow + c0 + 4 * j) = h[j] * rstd * gv; }
        }
    }
}
__device__ __forceinline__ void diff_combine_phase(const Frame& F) {
    unsigned char* ws = F.ws;
    const int gw = F.blk * 8 + F.wave, NGW = F.G * 8, lane = FLANE, c0 = 16 * lane;
    const float lam_init = 0.8f - 0.6f * 0.7408182206817179f;
    const float d1 = wave_sum(TT(lam_q1)[lane] * TT(lam_k1)[lane]), d2 = wave_sum(TT(lam_q2)[lane] * TT(lam_k2)[lane]);
    const float lam = expf(d1) - expf(d2) + lam_init;
    const bf16* OA = (const bf16*)(ws + R_OA); const bf16* OB = (const bf16*)(ws + R_OB); bf16* O1 = (bf16*)(ws + R_O1);
    float gs[16];
#pragma unroll
    for (int i = 0; i < 16; ++i) gs[i] = TT(gc_sub)[(c0 & 127) + i] * (1.f - lam_init);
    for (int row = gw; row < NLAT; row += NGW) {
        const u32x4 a0 = *(const u32x4*)(OA + (size_t)row * DM + c0), a1 = *(const u32x4*)(OA + (size_t)row * DM + c0 + 8);
        const u32x4 b0 = *(const u32x4*)(OB + (size_t)row * DM + c0), b1 = *(const u32x4*)(OB + (size_t)row * DM + c0 + 8);
        const unsigned aw[8] = {a0.x, a0.y, a0.z, a0.w, a1.x, a1.y, a1.z, a1.w}, bw[8] = {b0.x, b0.y, b0.z, b0.w, b1.x, b1.y, b1.z, b1.w};
        float o[16]; float s = 0.f;
#pragma unroll
        for (int i = 0; i < 8; ++i) { o[2 * i] = bflo(aw[i]) - lam * bflo(bw[i]); o[2 * i + 1] = bfhi(aw[i]) - lam * bfhi(bw[i]); s += o[2 * i] * o[2 * i] + o[2 * i + 1] * o[2 * i + 1]; }
        s += __shfl_xor(s, 1); s += __shfl_xor(s, 2); s += __shfl_xor(s, 4);
        const float rstd = rsqrtf(s * (1.f / 128.f) + EPS);
        float v0[8], v1[8];
#pragma unroll
        for (int i = 0; i < 8; ++i) { v0[i] = o[i] * rstd * gs[i]; v1[i] = o[8 + i] * rstd * gs[8 + i]; }
        store8(O1 + (size_t)row * DM + c0, v0); store8(O1 + (size_t)row * DM + c0 + 8, v1);
    }
}

#ifndef MOE_FUSED
#define MOE_FUSED 0
#endif
__device__ __forceinline__ int vcu_of(const Frame& F) { const unsigned v = F.MISC[11]; return v ? (int)v - 1 : F.blk; }
__device__ __forceinline__ void moe_gemm1_phase(const Frame& F, int l, int ntok) {
    unsigned char* ws = F.ws; moe_setup(F, l, ntok);
    SchedMoe S{(const LAS int*)(F.lds + LDS_PFX), (const LAS int*)(F.lds + LDS_CNT), (const int*)(ws + WS_LIST), 2, F.G, vcu_of(F), -1};
    pg8::Gemm g{(const bf16*)(ws + R_F), (const bf16*)(ws + WS_WGU), DM}; EpiGemm1 E{(bf16*)(ws + R_H)};
    pg8::gemm_phase<EpiGemm1, SchedMoe, true, true>(F.lds, g, S, E, F.wave);
}
__device__ __forceinline__ void moe_gemm2_phase(const Frame& F, int l, int ntok, const float* modl, const bool dry) {
    unsigned char* ws = F.ws; moe_setup(F, l, ntok);
    SchedMoe S{(const LAS int*)(F.lds + LDS_PFX), (const LAS int*)(F.lds + LDS_CNT), (const int*)(ws + WS_LIST), 4, F.G, vcu_of(F), -1};
    pg8::Gemm g{(const bf16*)(ws + R_H), (const bf16*)(ws + WS_WD), FF};
    EpiGemm2 E{(bf16*)(ws + R_YC), (const int*)(ws + WS_LIST), (const float*)(ws + WS_LW), (const LAS int*)(F.lds + LDS_CNT), F.out, (float*)(ws + WS_HCTX), modl, dry, (bf16*)(ws + R_H)};
    pg8::gemm_phase<EpiGemm2, SchedMoe, true, false>(F.lds, g, S, E, F.wave);
}
__device__ __forceinline__ void moe_fused_phase(const Frame& F, int l, int ntok, const float* modl, const bool dry) {
    unsigned char* ws = F.ws; LAS unsigned char* ring = F.lds;
    moe_setup(F, l, ntok);
    const LAS int* pfx = (const LAS int*)(F.lds + LDS_PFX); const LAS int* cnt = (const LAS int*)(F.lds + LDS_CNT);
    const int total = pfx[65];
    const bool xcd = false && (F.G & 7) == 0; const int x = F.blk & 7, j = F.blk >> 3, Gx = F.G >> 3, Tc = (total + 7) >> 3;
    for (int it = 0;; ++it) {
        int T;
        if (xcd) { const int Tl = it * Gx + j; T = x * Tc + Tl; if (Tl >= Tc || T >= total) break; }
        else { const unsigned v = F.MISC[11]; const int vcu = v ? (int)v - 1 : F.blk; T = it * F.G + vcu; if (T >= total) break; }
        { SchedMoe S{pfx, cnt, (const int*)(ws + WS_LIST), 2, F.G, F.blk, T};
          pg8::Gemm g{(const bf16*)(ws + R_F), (const bf16*)(ws + WS_WGU), DM}; EpiGemm1 E{(bf16*)(ws + R_H)};
          pg8::gemm_phase<EpiGemm1, SchedMoe, true, true>(ring, g, S, E, F.wave); }
        if (F.wave == 0 && lane_id() == 0) __builtin_amdgcn_fence(__ATOMIC_ACQUIRE, "agent");
        asm volatile("s_waitcnt vmcnt(0)" ::: "memory"); __syncthreads();
        if (!(dry && (RDS & 8)))
        { SchedMoe S{pfx, cnt, (const int*)(ws + WS_LIST), 4, F.G, F.blk, T};
          pg8::Gemm g{(const bf16*)(ws + R_H), (const bf16*)(ws + WS_WD), FF};
          EpiGemm2 E{(bf16*)(ws + R_YC), (const int*)(ws + WS_LIST), (const float*)(ws + WS_LW), cnt, F.out, (float*)(ws + WS_HCTX), modl, dry, (bf16*)(ws + R_H)};
          pg8::gemm_phase<EpiGemm2, SchedMoe, true, false>(ring, g, S, E, F.wave); }
    }
}

struct Args { Tensors T; int ph_lo, ph_hi, li, pad; };

__global__ void __launch_bounds__(512, 2) mk_fwd(Args args) {
    extern __shared__ __attribute__((aligned(16))) unsigned char lds_raw[];
    Frame F;
    F.lds = (LAS unsigned char*)lds_raw;
    F.MISC = (volatile LAS unsigned*)(F.lds + MISC_OFF);
    F.wave = __builtin_amdgcn_readfirstlane((int)threadIdx.x >> 6);
    F.G = gridDim.x; F.blk = blockIdx.x;
    F.out = args.T.out; F.ws = args.T.ws;
    unsigned char* ws = args.T.ws;
    F.ctl = (gu32*)(ws + WS_CTL);
    for (int u = FTID; u < (LDS_BYTES - LDSCTL_OFF) / 4; u += 512) ((LAS unsigned*)(F.lds + LDSCTL_OFF))[u] = 0u;
    __syncthreads();
    { LAS Tensors* tl = (LAS Tensors*)(F.lds + LDS_TENS); F.Tl = tl; if (FTID < (int)(sizeof(Tensors) / 8)) ((LAS unsigned long long*)tl)[FTID] = ((const unsigned long long*)&args.T)[FTID]; }
    __syncthreads();
    XcdBarrier bar; bar.bar = (unsigned*)(F.ctl + CW_BAR); bar.x = 0; bar.st = nullptr;
    if (MK_SINGLE) bar = xcd_barrier_post((unsigned*)(F.ctl + CW_BAR), F.MISC + 8, F.wave);
    const int lo = args.ph_lo, hi = args.ph_hi;
#ifndef PHMASK
#define PHMASK 0xFFFFFFFFu
#endif
#define IN(k) (((PHMASK >> (k)) & 1u) && lo <= (k) && (k) < hi)
#ifndef PHREP
#define PHREP 0u
#endif
#define PHASE(k, ...) do { if (IN(k)) { const bool dry_ = false; (void)dry_; __VA_ARGS__ } if (((PHREP >> (k)) & 1u) && IN(k)) { xcd_barrier(bar, F.wave); const bool dry_ = true; (void)dry_; __VA_ARGS__ } } while (0);
#define SEAM(k) do { if (IN(k) && IN((k) + 1)) xcd_barrier(bar, F.wave); } while (0)
    LAS unsigned char* ring = F.lds;
    const f32x2* R64 = (const f32x2*)(ws + WS_ROPE64); const f32x2* R32 = (const f32x2*)(ws + WS_ROPE32);
    const float* MOD0 = (const float*)(ws + WS_MOD); const float* MOD1 = MOD0 + 9 * 6144;
    float* HCTX = (float*)(ws + WS_HCTX);

    PHASE(0,  p0_prologue(F); ) SEAM(0);
    if (MK_SINGLE) { vcu_setup(bar, F.wave); __syncthreads(); }
    const int vcu = __builtin_amdgcn_readfirstlane(vcu_of(F)); const int cx = (F.G & 7) == 0 ? (vcu % (F.G >> 3)) * 8 + vcu / (F.G >> 3) : vcu;
    PHASE(1,
        const int gw = F.blk * 8 + F.wave, NGW = F.G * 8; bf16* XN = (bf16*)(ws + R_XN);
        for (int tok = gw; tok < NT; tok += NGW) { const bool lat = tok < NLAT; const int mr = lat ? (tok >> 11) : 8;
            const float* hrow = lat ? TT(x) + (size_t)tok * DM : TT(ctx) + (size_t)(tok - NLAT) * DM;
            normmod_row(hrow, TT(g_mix), MOD0 + mr * 6144, MOD0 + mr * 6144 + 1024, XN + (size_t)tok * DM, FLANE); }
    ) SEAM(1);
    PHASE(2,
        pg8::Gemm g{(const bf16*)(ws + R_XN), (const bf16*)(ws + WS_WIN0), DM}; pg8::StaticOrder S; S.init(NT, 1536, F.G, cx);
        EpiInProj0 E{(bf16*)(ws + R_CQ), (bf16*)(ws + R_CKV), (bf16*)(ws + R_KR), (bf16*)(ws + R_QS), (bf16*)(ws + R_KS), (bf16*)(ws + R_VS), R64, R32};
        pg8::gemm_phase<EpiInProj0, pg8::StaticOrder, true, false>(ring, g, S, E, F.wave);
    ) SEAM(2);
    PHASE(3,
        const int GA = (F.G * 27) / 64 > 0 ? (F.G * 27) / 64 : 1; const bool isq = F.blk < GA || F.G < 2;
        LAS float* rst = (LAS float*)(F.lds + LDS_RSTD);
        pg8::StaticOrder S;
        if (isq) S.init(NT, 768, F.G < 2 ? 1 : GA, F.blk); else S.init(NT, 1024, F.G - GA, F.blk - GA);
        const bf16* A = isq ? (const bf16*)(ws + R_CQ) : (const bf16*)(ws + R_CKV); const int K = isq ? 384 : 256;
        { pg8::Unit u; const int tid = FTID; const int row = tid >> 1, half = tid & 1, K2 = K >> 1;
          for (int i = 0; i < 4; ++i) { if (!S.next(i, u)) break;
              const bf16* rp = A + (size_t)(u.pm * 256 + row) * K + half * K2; float s = 0.f;
              for (int c = 0; c < K2; c += 64) {
                  u32x4 w[8];
_Pragma("unroll")
                  for (int q = 0; q < 8; ++q) w[q] = (c + 8 * q < K2) ? *(const u32x4*)(rp + c + 8 * q) : (u32x4){0u, 0u, 0u, 0u};
_Pragma("unroll")
                  for (int q = 0; q < 8; ++q) { const unsigned ww[4] = {w[q].x, w[q].y, w[q].z, w[q].w};
_Pragma("unroll")
                      for (int p = 0; p < 4; ++p) { const float a = bflo(ww[p]), b = bfhi(ww[p]); s += a * a + b * b; } } }
              s += __shfl_xor(s, 1);
              if (half == 0) rst[i * 256 + row] = rsqrtf(s / (float)K + EPS); }
          __syncthreads(); }
        { pg8::Gemm g{A, isq ? (const bf16*)(ws + WS_WUQ) : (const bf16*)(ws + WS_WUKV), K}; EpiUp E{isq ? (bf16*)(ws + R_Q) : (bf16*)(ws + R_KV), rst, R32, isq ? 768 : 1024, isq};
          pg8::gemm_phase<EpiUp, pg8::StaticOrder, true, false>(ring, g, S, E, F.wave); }
        if (F.G < 2) {   }
    ) SEAM(3);
    PHASE(4,
        const bf16* Q = (const bf16*)(ws + R_Q); const bf16* KV = (const bf16*)(ws + R_KV); const bf16* KR = (const bf16*)(ws + R_KR);
        const bf16* QS = (const bf16*)(ws + R_QS); const bf16* KS = (const bf16*)(ws + R_KS); const bf16* VS = (const bf16*)(ws + R_VS); bf16* O = (bf16*)(ws + R_O);
        const float sc_mla = 0.10206207261596575f, sc_swa = 0.125f;
        for (int U = vcu; U < 512; U += F.G) {
            const int b = U >> 6, h = (U >> 3) & 7, qb = U & 7; const int row0 = b * SEQ + qb * 256;
            att::Unit u{Q + (size_t)row0 * 768 + h * 96, 768, KV + h * 128, 1024, KR, 32, KV + h * 128 + 64, 1024, O + (size_t)row0 * DM + h * 64, DM, NLAT + b * CTXL, 4, b * SEQ, 32, 0, 0, 0.f};
            att::unit<96, 8, 64, false, false>(u, sc_mla, ring, F.wave);
        }
        for (int U = vcu; U < 512; U += F.G) {
            const int b = U >> 6, h = (U >> 3) & 7, qb = U & 7; const int row0 = b * SEQ + qb * 256; const int kvh = h >> 2;
            const int klo = qb * 256 - 128 < 0 ? 0 : qb * 256 - 128, khi = qb * 256 + 384 > SEQ ? SEQ : qb * 256 + 384;
            att::Unit u{QS + (size_t)row0 * 512 + h * 64, 512, KS + kvh * 64, 128, KS, 128, VS + kvh * 64, 128, O + (size_t)row0 * DM + 512 + h * 64, DM, NLAT + b * CTXL, 4, b * SEQ + klo, (khi - klo) >> 6, qb * 256, klo, TT(wa_sink)[h]};
            att::unit<64, 8, 64, true, true>(u, sc_swa, ring, F.wave);
        }
        for (int U = vcu; U < 128; U += F.G) {
            const int b = (U & 63) >> 3, h = U & 7; const int row0 = NLAT + b * CTXL;
            if (U < 64) { att::Unit u{Q + (size_t)row0 * 768 + h * 96, 768, KV + h * 128, 1024, KR, 32, KV + h * 128 + 64, 1024, O + (size_t)row0 * DM + h * 64, DM, row0, 4, 0, 0, 0, 0, 0.f};
                att::unit<96, 8, 64, false, false>(u, sc_mla, ring, F.wave); }
            else { const int kvh = h >> 2; att::Unit u{QS + (size_t)row0 * 512 + h * 64, 512, KS + kvh * 64, 128, KS, 128, VS + kvh * 64, 128, O + (size_t)row0 * DM + 512 + h * 64, DM, row0, 4, 0, 0, 0, 0, TT(wa_sink)[h]};
                att::unit<64, 8, 64, true, true>(u, sc_swa, ring, F.wave); }
        }
    ) SEAM(4);
    PHASE(5,
        pg8::Gemm g{(const bf16*)(ws + R_O), (const bf16*)(ws + WS_WOUT0), DM}; pg8::StaticOrder S; S.init(NT, DM, F.G, cx);
        EpiOutProj E{TT(x), TT(ctx), F.out, HCTX, MOD0};
        pg8::gemm_phase<EpiOutProj, pg8::StaticOrder, true, false>(ring, g, S, E, F.wave);
    ) SEAM(5);
    PHASE(6,  if ((vcu_of(F) & 1) && !dry_) { convert_expert_weights(F, 0); __syncthreads(); route_phase(F, 0, NT, dry_); } else { route_phase(F, 0, NT, dry_); if (!dry_) convert_expert_weights(F, 0); } ) SEAM(6);
#if MOE_FUSED
    PHASE(7,  moe_fused_phase(F, 0, NT, MOD0, dry_); ) SEAM(7);
    SEAM(8);
#else
    PHASE(7,  moe_gemm1_phase(F, 0, NT); ) SEAM(7);
    PHASE(8,  moe_gemm2_phase(F, 0, NT, MOD0, dry_); ) SEAM(8);
#endif
    PHASE(9,  combine_phase(F, 0, NT, dry_); ) SEAM(9);
    PHASE(10,
        pg8::Gemm g{(const bf16*)(ws + R_A1), (const bf16*)(ws + WS_WIN1), DM}; pg8::StaticOrder S; S.init(NT, 3072, F.G, cx);
        EpiInProj1 E{(bf16*)(ws + R_P1), R64};
        pg8::gemm_phase<EpiInProj1, pg8::StaticOrder, true, false>(ring, g, S, E, F.wave);
    ) SEAM(10);
    PHASE(11,
        const bf16* P1 = (const bf16*)(ws + R_P1);
        const int lane_ = FLANE; const float lam_init = 0.8f - 0.6f * 0.7408182206817179f;
        const float d1 = wave_sum(TT(lam_q1)[lane_] * TT(lam_k1)[lane_]); const float d2 = wave_sum(TT(lam_q2)[lane_] * TT(lam_k2)[lane_]);
        const float lam = expf(d1) - expf(d2) + lam_init;
        for (int U = vcu; U < 1024; U += F.G) {
            const int q16 = U & 15, h = (U >> 4) & 7, b = U >> 7;
            att::UnitD u{P1, 3072, h * 384, h * 384 + 128, h * 384 + 256, (bf16*)(ws + R_O1) + h * 128, DM, b * SEQ + q16 * 128, NLAT + b * CTXL, 4, b * SEQ, 32, lam, 1.f - lam_init, TT(gc_sub)};
            att::unit_diff(u, 0.125f, ring, F.wave);
        }
    ) SEAM(11);
    PHASE(13,
        pg8::Gemm g{(const bf16*)(ws + R_O1), (const bf16*)(ws + WS_WOUT1), DM}; pg8::StaticOrder S; S.init(NLAT, DM, F.G, cx);
        EpiOutProj E{F.out, HCTX, F.out, HCTX, MOD1};
        pg8::gemm_phase<EpiOutProj, pg8::StaticOrder, true, false>(ring, g, S, E, F.wave);
    ) SEAM(13);
    PHASE(14,  if ((vcu_of(F) & 1) && !dry_) { convert_expert_weights(F, 1); __syncthreads(); route_phase(F, 1, NLAT, dry_); } else { route_phase(F, 1, NLAT, dry_); if (!dry_) convert_expert_weights(F, 1); } ) SEAM(14);
#if MOE_FUSED
    PHASE(15,  moe_fused_phase(F, 1, NLAT, MOD1, dry_); ) SEAM(15);
    SEAM(16);
#else
    PHASE(15,  moe_gemm1_phase(F, 1, NLAT); ) SEAM(15);
    PHASE(16,  moe_gemm2_phase(F, 1, NLAT, MOD1, dry_); ) SEAM(16);
#endif
    PHASE(17,  combine_phase(F, 1, NLAT, dry_); )
#undef IN
#undef SEAM
}

extern "C" void kernel_launch(void* const* d_in, const int* in_sizes, int n_in, void* d_out, int out_size, void* d_ws, size_t ws_size, hipStream_t stream) {
    static int grid = 0;
    if (grid == 0) {
        if (n_in != 31 || in_sizes[0] != NLAT * DM || out_size != NLAT * DM || ws_size < WS_END) {
            fprintf(stderr, "kernel_launch: unexpected shapes: n_in %d in0 %d out %d ws %zu (need %zu); nothing launched\n", n_in, n_in > 0 ? in_sizes[0] : -1, out_size, ws_size, (size_t)WS_END); grid = -1; return; }
        int dev = 0, cus = 0;
        if (hipGetDevice(&dev) != hipSuccess || hipDeviceGetAttribute(&cus, hipDeviceAttributeMultiprocessorCount, dev) != hipSuccess) { grid = -1; return; }
        if (hipFuncSetAttribute((const void*)mk_fwd, hipFuncAttributeMaxDynamicSharedMemorySize, LDS_BYTES) != hipSuccess) { fprintf(stderr, "kernel_launch: hipFuncSetAttribute failed\n"); grid = -1; return; }
        int per_cu = 0;
        if (hipOccupancyMaxActiveBlocksPerMultiprocessor(&per_cu, (const void*)mk_fwd, 512, LDS_BYTES) != hipSuccess || per_cu < 1) fprintf(stderr, "kernel_launch: occupancy query says %d blocks per CU\n", per_cu);
        (void)hipGetLastError();
        grid = cus;
    }
    if (grid < 0) return;
    (void)hipMemsetAsync((char*)d_ws + WS_CTL, 0, CTL_ZERO_BYTES, stream);
    Args a{};
    const float** tp = (const float**)&a.T;
    for (int i = 0; i < 31; ++i) tp[i] = (const float*)d_in[i];
    a.T.out = (float*)d_out; a.T.ws = (unsigned char*)d_ws;
    if (MK_SINGLE) { a.ph_lo = 0; a.ph_hi = NPH; a.li = 0; hipLaunchKernelGGL(mk_fwd, dim3(grid), dim3(512), LDS_BYTES, stream, a); }
    else { for (int p = 0; p < NPH; ++p) { a.ph_lo = p; a.ph_hi = p + 1; a.li = p; hipLaunchKernelGGL(mk_fwd, dim3(grid), dim3(512), LDS_BYTES, stream, a); } }
    const hipError_t le = hipPeekAtLastError();
    if (le != hipSuccess) fprintf(stderr, "kernel_launch: launch failed: %s\n", hipGetErrorName(le));
}
```

```cpp
#include <hip/hip_runtime.h>
#include <cstdio>
#include <cstdint>

__device__ __forceinline__ int lane_id() { int l; asm volatile("v_mbcnt_lo_u32_b32 %0, -1, 0\n\tv_mbcnt_hi_u32_b32 %0, -1, %0" : "=v"(l)); return l; }
#define RDS 0
#define P4REP_MLA 1
#define PADSTR "4"
#define P4REP_SWA 1
#ifndef MK_SINGLE
#define MK_SINGLE 1
#endif

constexpr int DM = 1024, NB = 8, SEQ = 2048, CTXL = 256;
constexpr int NLAT = NB * SEQ;
constexpr int NCTX = NB * CTXL;
constexpr int NT = NLAT + NCTX;
constexpr int NEXP = 64, FF = 256;
constexpr float EPS = 1e-6f;
constexpr int NPH = 18;

namespace pg8 {
#define PG8_LAS __attribute__((address_space(3)))
typedef unsigned short bf16_t;
typedef short bf16x8 __attribute__((ext_vector_type(8)));
typedef float f32x4 __attribute__((ext_vector_type(4)));
typedef unsigned u32x4 __attribute__((ext_vector_type(4)));
constexpr int BM = 256, BK = 64, HALF = 128, HTB = HALF * BK * 2, STAGE_BYTES = 8 * HTB, NXCD = 8, WGM = 8;

__host__ __device__ __forceinline__ int lds_byte(int r, int c) { const int st = (r >> 4) * 2 + (c >> 5), rr = r & 15, cc = c & 31, ob = rr * 64 + cc * 2; return st * 1024 + (ob ^ (((ob >> 9) & 1) << 5)); }
__host__ __device__ __forceinline__ void stage_rc(int b, int& R, int& C) { const int st = b / 1024, sb = b % 1024, swz = sb ^ (((sb >> 9) & 1) << 5); R = (st >> 1) * 16 + swz / 64; C = (st & 1) * 32 + (swz % 64) / 2; }
__host__ __device__ __forceinline__ int perm32(int rho) { const int n = rho >> 4, i = rho & 15; return 8 * (i >> 2) + 4 * n + (i & 3); }

struct Unit { int pm, pn, e, r, hf; };
struct Gemm { const bf16_t* A; const bf16_t* Bt; int K; };

template <bool SPLIT>
struct StaticOrderT {
    int nM, nN, nwg, G, c, nfull;
    __device__ __forceinline__ void init(int M, int N, int G_, int c_) { nM = M / BM; nN = N / BM; nwg = nM * nN; G = G_; c = c_;
        nfull = nwg; if (SPLIT) { const int nf = (nwg / G) * G, rem = nwg - nf; if (rem > 0 && 2 * rem <= G) nfull = nf; } }
    __device__ __forceinline__ bool next(int i, Unit& u) const {
        const long L = (long)i * G + c; int wgid; u.hf = 0;
        if (!SPLIT) { if (L >= nwg) return false; wgid = (int)L; }
        else if (L < nfull) wgid = (int)L;
        else { const long j = L - nfull; wgid = nfull + (int)(j >> 1); if (wgid >= nwg) return false; u.hf = 1 + (int)(j & 1); }
        { const int q = nwg / NXCD, r = nwg % NXCD, xcd = wgid % NXCD, off = wgid / NXCD; wgid = (xcd < r ? xcd * (q + 1) : r * (q + 1) + (xcd - r) * q) + off; }
        const int nig = WGM * nN, gid = wgid / nig, fm = gid * WGM, gsz = (nM - fm) < WGM ? (nM - fm) : WGM;
        u.pm = fm + ((wgid % nig) % gsz); u.pn = (wgid % nig) / gsz; u.e = 0; u.r = i; return true;
    }
    __device__ __forceinline__ unsigned row_off(const Unit&, int) const { return 0u; }
};
typedef StaticOrderT<false> StaticOrder;
typedef StaticOrderT<true> StaticOrderSplit;

__device__ __forceinline__ unsigned cvt_pk_bf16(float lo, float hi) { unsigned r; asm volatile("v_cvt_pk_bf16_f32 %0, %1, %2" : "=v"(r) : "v"(lo), "v"(hi)); return r; }

template <class E, class = void> struct epi_wide { static constexpr bool value = false; };
template <class E> struct epi_wide<E, decltype((void)E::WIDE)> { static constexpr bool value = E::WIDE; };
template <class Epi, class Sched, bool ALIGN_EPI, bool GATHER, bool RLX = false>
__device__ __forceinline__ void gemm_phase(PG8_LAS unsigned char* lds, const Gemm g, const Sched& S, const Epi& E, const int wid) {
    const int lane = lane_id(), tid = wid * 64 + lane, wr = wid >> 2, wc = wid & 3, fr = lane & 15, fq = lane >> 4;
    const int K = g.K, nt = K / BK;
    unsigned voffA[2], voffB[2]; int Rr[2]; int Cc = 0;
    constexpr bool WIDE = epi_wide<Epi>::value;
#pragma unroll
    for (int i = 0; i < 2; ++i) { int R, C; stage_rc(tid * 16 + i * 8192, R, C); const int Rb = WIDE ? (64 * (R >> 5) + perm32(R & 31)) : (Epi::PERM ? ((R & ~31) + perm32(R & 31)) : R);
        voffA[i] = (unsigned)(R * K + C) * 2u; voffB[i] = (unsigned)(Rb * K + C) * 2u; Rr[i] = R; Cc = C; }
    const size_t kstep = (size_t)(BK * 2);
    const size_t hstep = (size_t)HALF * K * 2;
    const size_t tstep = 2 * hstep;
    const size_t hstepB = WIDE ? (size_t)32 * K * 2 : hstep;
    const unsigned ldsw = (unsigned)wid * 1024u;
    const int aoff = lds_byte(wr * 64 + fr, fq * 8), boff = lds_byte(wc * 32 + fr, fq * 8);
#define PG8_SA(b, h) (((b) * 2 + (h)) * HTB)
#define PG8_SB(b, h) ((4 + (b) * 2 + (h)) * HTB)
#define PG8_STAGE(bufoff, gbase, voff) do { _Pragma("unroll") for (int _i = 0; _i < 2; ++_i) \
        __builtin_amdgcn_global_load_lds((const unsigned*)((const char*)(gbase) + (voff)[_i]), (PG8_LAS unsigned*)(lds + (bufoff) + ldsw + _i * 8192), 16, 0, 0); } while (0)
#define PG8_STAGE_A(bufoff, ub, kb, h) do { if constexpr (GATHER) { _Pragma("unroll") for (int _i = 0; _i < 2; ++_i) \
        __builtin_amdgcn_global_load_lds((const unsigned*)((const char*)g.A + (size_t)gA[h][_i] + (kb)), (PG8_LAS unsigned*)(lds + (bufoff) + ldsw + _i * 8192), 16, 0, 0); } \
        else { PG8_STAGE(bufoff, (ub) + (kb) + (h) * hstep, voffA); } } while (0)
#define PG8_LDA(dst, b, h) do { _Pragma("unroll") for (int m = 0; m < 4; ++m) _Pragma("unroll") for (int k = 0; k < 2; ++k) dst[m][k] = *(const PG8_LAS bf16x8*)(lds + PG8_SA(b, h) + aoff + m * 2048 + k * 1024); } while (0)
#define PG8_LDB(dst, b, h) do { _Pragma("unroll") for (int n = 0; n < 2; ++n) _Pragma("unroll") for (int k = 0; k < 2; ++k) dst[n][k] = *(const PG8_LAS bf16x8*)(lds + PG8_SB(b, h) + boff + n * 2048 + k * 1024); } while (0)
#define PG8_MMA(ai, bj, At, Bt) do { __builtin_amdgcn_s_setprio(1); _Pragma("unroll") for (int m = 0; m < 4; ++m) _Pragma("unroll") for (int n = 0; n < 2; ++n) _Pragma("unroll") for (int k = 0; k < 2; ++k) \
        acc[ai][bj][m][n] = __builtin_amdgcn_mfma_f32_16x16x32_bf16(Bt[n][k], At[m][k], acc[ai][bj][m][n], 0, 0, 0); __builtin_amdgcn_s_setprio(0); } while (0)
#define PG8_WAIT_V(n) asm volatile("s_waitcnt vmcnt(" #n ")" ::: "memory")
#define PG8_WAIT_VR(r) asm volatile("s_cmp_eq_u32 %0, 0\n\ts_cbranch_scc0 .Lrlx%=\n\ts_waitcnt vmcnt(8)\n.Lrlx%=:" :: "s"(r) : "scc", "memory")
#define PG8_WAIT_L(n) asm volatile("s_waitcnt lgkmcnt(" #n ")" ::: "memory")
#define PG8_BAR __builtin_amdgcn_s_barrier()
#define PG8_SCHED __builtin_amdgcn_sched_barrier(0)
    Unit cur, nxt; int ui = 0;
    if (!S.next(0, cur)) return;
    unsigned gA[2][2] = {{0u, 0u}, {0u, 0u}};
    if constexpr (GATHER) {
#pragma unroll
        for (int h = 0; h < 2; ++h)
#pragma unroll
            for (int i = 0; i < 2; ++i) gA[h][i] = S.row_off(cur, h * HALF + Rr[i]) + (unsigned)Cc * 2u;
    }
    f32x4 acc[2][2][4][2];
#pragma unroll
    for (int a = 0; a < 2; ++a)
#pragma unroll
        for (int b = 0; b < 2; ++b)
#pragma unroll
            for (int m = 0; m < 4; ++m)
#pragma unroll
                for (int n = 0; n < 2; ++n) acc[a][b][m][n] = (f32x4){0.f, 0.f, 0.f, 0.f};
    bf16x8 At[4][2], B0[2][2], B1[2][2];
    const char* cA = (const char*)g.A + (GATHER ? (size_t)0 : (size_t)cur.pm * tstep + (cur.hf == 2 ? hstep : (size_t)0)); const char* cB = (const char*)g.Bt + (size_t)cur.pn * tstep;
    PG8_STAGE(PG8_SB(0, 0), cB, voffB); PG8_STAGE(PG8_SB(0, 1), cB + hstepB, voffB); PG8_STAGE_A(PG8_SA(0, 0), cA, 0, 0); PG8_STAGE_A(PG8_SA(0, 1), cA, 0, 1);
    if (wr == 1) PG8_BAR;
    PG8_WAIT_V(2); PG8_BAR;
    PG8_STAGE(PG8_SB(1, 0), cB + kstep, voffB); PG8_STAGE_A(PG8_SA(1, 0), cA, kstep, 0); PG8_STAGE(PG8_SB(1, 1), cB + hstepB + kstep, voffB);
    if constexpr (RLX) PG8_WAIT_V(0); else PG8_WAIT_V(6);
    PG8_BAR;
    for (;;) {
        const bool has_next = S.next(ui + 1, nxt);
        const char* nA = (has_next && !GATHER) ? (const char*)g.A + (size_t)nxt.pm * tstep + (nxt.hf == 2 ? hstep : (size_t)0) : cA; const char* nB = has_next ? (const char*)g.Bt + (size_t)nxt.pn * tstep : cB;
        for (int t = 0; t < nt; t += 2) {
            const bool last = (t == nt - 2);
            const bool rlx = RLX && (t == 0);
            const size_t ka1 = (size_t)(t + 1) * kstep;
            const size_t ka2 = last ? (size_t)0 : (size_t)(t + 2) * kstep; const size_t ka3 = ka2 + kstep;
            const char* a2 = last ? nA : cA;
            const char* b2 = last ? nB : cB + (size_t)(t + 2) * kstep; const char* b3 = b2 + kstep;
            unsigned gN[2][2] = {{0u, 0u}, {0u, 0u}};
            if constexpr (GATHER) { if (last && has_next) {
#pragma unroll
                for (int h = 0; h < 2; ++h)
#pragma unroll
                    for (int i = 0; i < 2; ++i) gN[h][i] = S.row_off(nxt, h * HALF + Rr[i]) + (unsigned)Cc * 2u; } }
            PG8_LDB(B0, 0, 0); PG8_LDB(B1, 0, 1); PG8_SCHED; PG8_LDA(At, 0, 0); PG8_STAGE_A(PG8_SA(1, 1), cA, ka1, 1);
            if (!rlx) PG8_WAIT_V(8); PG8_WAIT_L(0); PG8_BAR; PG8_MMA(0, 0, At, B0); PG8_MMA(0, 1, At, B1); PG8_BAR; PG8_SCHED;
            if constexpr (GATHER) { if (last && has_next) {
#pragma unroll
                for (int h = 0; h < 2; ++h)
#pragma unroll
                    for (int i = 0; i < 2; ++i) gA[h][i] = gN[h][i]; } }
            if (cur.hf == 0) { PG8_LDA(At, 0, 1); } PG8_STAGE(PG8_SB(0, 0), b2, voffB); PG8_STAGE(PG8_SB(0, 1), b2 + hstepB, voffB); PG8_STAGE_A(PG8_SA(0, 0), a2, ka2, 0);
            if (!rlx) PG8_WAIT_V(8); PG8_WAIT_L(0); PG8_BAR; if (cur.hf == 0) { PG8_MMA(1, 0, At, B0); PG8_MMA(1, 1, At, B1); } PG8_BAR; PG8_SCHED;
            PG8_LDB(B0, 1, 0); PG8_LDB(B1, 1, 1); PG8_SCHED; PG8_LDA(At, 1, 0); PG8_STAGE_A(PG8_SA(0, 1), a2, ka2, 1);
            if (!rlx) PG8_WAIT_V(8); PG8_WAIT_L(0); PG8_BAR; PG8_MMA(0, 0, At, B0); PG8_MMA(0, 1, At, B1); PG8_BAR; PG8_SCHED;
            if (cur.hf == 0) { PG8_LDA(At, 1, 1); } PG8_STAGE(PG8_SB(1, 0), b3, voffB); PG8_STAGE(PG8_SB(1, 1), b3 + hstepB, voffB); PG8_STAGE_A(PG8_SA(1, 0), a2, ka3, 0);
            PG8_WAIT_V(8); PG8_WAIT_L(0); PG8_BAR; if (cur.hf == 0) { PG8_MMA(1, 0, At, B0); PG8_MMA(1, 1, At, B1); } PG8_BAR; PG8_SCHED;
        }
        if constexpr (ALIGN_EPI) { if (wr == 0) PG8_BAR; }
        if constexpr (RLX) PG8_WAIT_V(0);
        E(acc, cur, wr, wc, fr, fq);
        if (!has_next) break;
#pragma unroll
        for (int a = 0; a < 2; ++a)
#pragma unroll
            for (int b = 0; b < 2; ++b)
#pragma unroll
                for (int m = 0; m < 4; ++m)
#pragma unroll
                    for (int n = 0; n < 2; ++n) acc[a][b][m][n] = (f32x4){0.f, 0.f, 0.f, 0.f};
        cur = nxt; cA = nA; cB = nB; ++ui;
        if constexpr (ALIGN_EPI) { if (wr == 1) PG8_BAR; }
    }
    PG8_WAIT_V(0);
    if constexpr (!ALIGN_EPI) { if (wr == 0) PG8_BAR; }
    PG8_BAR;
#undef PG8_SA
#undef PG8_SB
#undef PG8_STAGE
#undef PG8_STAGE_A
#undef PG8_LDA
#undef PG8_LDB
#undef PG8_MMA
#undef PG8_WAIT_V
#undef PG8_WAIT_L
#undef PG8_BAR
#undef PG8_SCHED
}
}

#define GAS __attribute__((address_space(1)))
#define LAS __attribute__((address_space(3)))
typedef unsigned short bf16;
typedef pg8::f32x4 f32x4;
typedef pg8::u32x4 u32x4;
typedef pg8::bf16x8 bf16x8;
typedef float f32x2 __attribute__((ext_vector_type(2)));
typedef float f32x16 __attribute__((ext_vector_type(16)));
typedef short s16x4 __attribute__((ext_vector_type(4)));
typedef unsigned u32x2 __attribute__((ext_vector_type(2)));
using pg8::cvt_pk_bf16;

__device__ __forceinline__ float bf2f(unsigned short b) { return __uint_as_float(((unsigned)b) << 16); }
__device__ __forceinline__ float bflo(unsigned w) { return __uint_as_float(w << 16); }
__device__ __forceinline__ float bfhi(unsigned w) { return __uint_as_float(w & 0xffff0000u); }
__device__ __forceinline__ float wave_sum(float v) {
#pragma unroll
    for (int o = 1; o < 64; o <<= 1) v += __shfl_xor(v, o);
    return v;
}
__device__ __forceinline__ void store8_nt(bf16* p, const float (&v)[8]) {
    u32x4 w; w.x = cvt_pk_bf16(v[0], v[1]); w.y = cvt_pk_bf16(v[2], v[3]); w.z = cvt_pk_bf16(v[4], v[5]); w.w = cvt_pk_bf16(v[6], v[7]);
    __builtin_nontemporal_store(w, (u32x4*)p);
}
__device__ __forceinline__ void store16_wt(void* p, const u32x4 v) { asm volatile("global_store_dwordx4 %0, %1, off sc0 sc1 nt\n\ts_nop 1" :: "v"(p), "v"(v) : "memory"); }
__device__ __forceinline__ void store8(bf16* p, const float (&v)[8]) {
    u32x4 w; w.x = cvt_pk_bf16(v[0], v[1]); w.y = cvt_pk_bf16(v[2], v[3]); w.z = cvt_pk_bf16(v[4], v[5]); w.w = cvt_pk_bf16(v[6], v[7]);
    *(u32x4*)p = w;
}
__device__ __forceinline__ void rope8(float (&v)[8], const f32x2* tab) {
    const f32x4 t0 = *(const f32x4*)tab, t1 = *(const f32x4*)(tab + 2);
    const float c[4] = {t0[0], t0[2], t1[0], t1[2]}, s[4] = {t0[1], t0[3], t1[1], t1[3]};
#pragma unroll
    for (int i = 0; i < 4; ++i) { const float a = v[2 * i], b = v[2 * i + 1]; v[2 * i] = a * c[i] - b * s[i]; v[2 * i + 1] = b * c[i] + a * s[i]; }
}
#define ACC8(v, A, ai, bj, m) do { const f32x4 _x0 = A[ai][bj][m][0], _x1 = A[ai][bj][m][1]; v[0] = _x0[0]; v[1] = _x0[1]; v[2] = _x0[2]; v[3] = _x0[3]; v[4] = _x1[0]; v[5] = _x1[1]; v[6] = _x1[2]; v[7] = _x1[3]; } while (0)
typedef const f32x4 (&AccRef)[2][2][4][2];

#ifndef MOE_FUSED
#define MOE_FUSED 0
#endif
constexpr size_t MiB = 1u << 20;
constexpr size_t WS_CTL = 0, CTL_ZERO_BYTES = 1 * MiB;
constexpr size_t WS_MOD = 1 * MiB;
constexpr size_t WS_ROPE64 = 1 * MiB + 512 * 1024;
constexpr size_t WS_ROPE32 = 2 * MiB;
constexpr size_t WS_LIST = 3 * MiB;
constexpr size_t WS_W8 = 8 * MiB;
constexpr size_t WS_WIN0 = 9 * MiB;
constexpr size_t WS_WUQ = 12 * MiB;
constexpr size_t WS_WUKV = 13 * MiB;
constexpr size_t WS_WOUT0 = 14 * MiB;
constexpr size_t WS_WIN1 = 16 * MiB;
constexpr size_t WS_WOUT1 = 22 * MiB;
constexpr size_t WS_HCTX = 24 * MiB;
constexpr size_t R_HB_OFF = 208;
constexpr size_t WS_WGU = 32 * MiB;
constexpr size_t WS_WD = 97 * MiB;
constexpr size_t WS_R = 130 * MiB;
constexpr size_t R_HB = WS_R + R_HB_OFF * MiB;
constexpr size_t R_YC = WS_R;
constexpr size_t WS_YS = WS_R + 180 * MiB;
constexpr size_t R_H = WS_R + 288 * MiB;
#if MOE_FUSED
constexpr size_t R_F = WS_R + 324 * MiB;
constexpr size_t WS_END = R_F + 36 * MiB;
#else
constexpr size_t R_F = WS_R;
constexpr size_t WS_LW = R_H + 89 * MiB;
constexpr size_t WS_END = WS_LW + 5 * MiB;
#endif
constexpr size_t R_XN = WS_R;
constexpr size_t R_CQ = WS_R + 36 * MiB;
constexpr size_t R_CKV = WS_R + 50 * MiB;
constexpr size_t R_KR = WS_R + 59 * MiB;
constexpr size_t R_SSQ = WS_R + 188 * MiB;
constexpr size_t R_QS = WS_R + 61 * MiB;
constexpr size_t R_KS = WS_R + 79 * MiB;
constexpr size_t R_VS = WS_R + 84 * MiB;
constexpr size_t R_Q = WS_R + 89 * MiB;
constexpr size_t R_KV = WS_R + 116 * MiB;
constexpr size_t R_O = WS_R + 152 * MiB;
constexpr size_t R_A1 = R_H;
constexpr size_t R_P1 = WS_R;
constexpr size_t R_OA = WS_R + 108 * MiB;
constexpr size_t R_OB = WS_R + 140 * MiB;
constexpr size_t R_O1 = WS_R + 172 * MiB;
constexpr int CW_TMO = 0, CW_CODE = 1, CW_BAR = 4096, CW_CNT = 16384;
constexpr int RING_BYTES = 131072, LDSCTL_OFF = RING_BYTES, MISC_OFF = LDSCTL_OFF + 320;
constexpr int LDS_PFX = 132096;
constexpr int LDS_CNT = 132096 + 320;
constexpr int LDS_RSTD = 133120;
constexpr int LDS_UTAB = 137216;
constexpr int LDS_TENS = 134144 + 4096;
constexpr int LDS_BYTES = 147456;

struct Tensors {
    const float *x, *c, *ctx, *c_ctx, *w_ada, *b_ada, *g_mix, *g_ffn, *wa_in, *ga_q, *ga_kv, *wa_uq, *wa_ukv, *wa_sink, *wa_out, *wc_in,
        *lam_q1, *lam_k1, *lam_q2, *lam_k2, *gc_sub, *wc_out, *w_router, *b_router, *we_gate, *we_up, *we_down, *ws_gate, *ws_up, *ws_down, *g_final;
    float* out; unsigned char* ws;
};

constexpr float QSC_MLA = 0.10206207261596575f * 1.4426950408889634f, QSC_D64 = 0.125f * 1.4426950408889634f;
struct EpiInProj0 {
    static constexpr bool PERM = true;
    bf16 *CQ, *CKV, *KR, *QS, *KS, *VS; const f32x2 *R64, *R32; float* SSQ;
    __device__ __forceinline__ void operator()(AccRef acc, const pg8::Unit& u, int wr, int wc, int fr, int fq) const {
        { const int l_ = lane_id(); fr = l_ & 15; fq = l_ >> 4; }
        const bool lat = u.pm < NLAT / 256;
#pragma unroll
        for (int bj = 0; bj < 2; ++bj) {
            const int col0 = u.pn * 256 + bj * 128 + wc * 32 + 8 * fq;
            const int cg = __builtin_amdgcn_readfirstlane(col0 >> 5);
            if (cg >= 45) continue;
#pragma unroll
            for (int ai = 0; ai < 2; ++ai)
#pragma unroll
                for (int m = 0; m < 4; ++m) {
                    const int row = u.pm * 256 + ai * 128 + wr * 64 + m * 16 + fr; const int t = row & (SEQ - 1);
                    float v[8]; ACC8(v, acc, ai, bj, m);
                    if (cg < 20) {
                        float s_ = (v[0] * v[0] + v[1] * v[1]) + (v[2] * v[2] + v[3] * v[3]) + (v[4] * v[4] + v[5] * v[5]) + (v[6] * v[6] + v[7] * v[7]);
                        s_ += __shfl_xor(s_, 16); s_ += __shfl_xor(s_, 32);
                        if (fq == 0) SSQ[(size_t)row * 20 + cg] = s_; }
                    if (cg < 12) store8(CQ + (size_t)row * 384 + col0, v);
                    else if (cg < 20) store8(CKV + (size_t)row * 256 + (col0 - 384), v);
                    else if (cg < 21) { const int c = col0 - 640; if (lat) rope8(v, R32 + t * 16 + (c >> 1)); store8(KR + (size_t)row * 32 + c, v); }
                    else if (cg < 37) { const int c = col0 - 672; if (lat) rope8(v, R64 + t * 32 + ((c & 63) >> 1));
_Pragma("unroll")
                        for (int i = 0; i < 8; ++i) v[i] *= QSC_D64;
                        store8(QS + (size_t)row * 512 + c, v); }
                    else if (cg < 41) { const int c = col0 - 1184; if (lat) rope8(v, R64 + t * 32 + ((c & 63) >> 1)); store8(KS + (size_t)row * 128 + c, v); }
                    else { const int c = col0 - 1312; store8(VS + (size_t)row * 128 + c, v); }
                }
        }
    }
};
struct EpiUp {
    static constexpr bool PERM = true;
    bf16* O; const LAS float* rstd; const f32x2* R32; int LDC; bool ISQ;
    __device__ __forceinline__ void operator()(AccRef acc, const pg8::Unit& u, int wr, int wc, int fr, int fq) const {
        { const int l_ = lane_id(); fr = l_ & 15; fq = l_ >> 4; }
        const bool lat = u.pm < NLAT / 256;
#pragma unroll
        for (int bj = 0; bj < 2; ++bj) {
            const int col0 = u.pn * 256 + bj * 128 + wc * 32 + 8 * fq;
            const int cg = __builtin_amdgcn_readfirstlane(col0 >> 5);
            const bool rp = ISQ && lat && (cg % 3 == 2);
#pragma unroll
            for (int ai = 0; ai < 2; ++ai)
#pragma unroll
                for (int m = 0; m < 4; ++m) {
                    const int rl = ai * 128 + wr * 64 + m * 16 + fr; const int row = u.pm * 256 + rl; const int t = row & (SEQ - 1);
                    const float rs = rstd[(u.r & 3) * 256 + rl] * (ISQ ? QSC_MLA : 1.f);
                    float v[8]; ACC8(v, acc, ai, bj, m);
#pragma unroll
                    for (int i = 0; i < 8; ++i) v[i] *= rs;
                    if (rp) rope8(v, R32 + t * 16 + ((col0 & 31) >> 1));
                    store8(O + (size_t)row * LDC + col0, v);
                }
        }
    }
};
template <bool IN_F32>
struct EpiOutProjT {
    static constexpr bool PERM = true;
    const float* xlat; const float* xctx; const bf16* hin; bf16* hout; const float* mod;
    __device__ __forceinline__ void operator()(AccRef acc, const pg8::Unit& u, int wr, int wc, int fr, int fq) const {
        { const int l_ = lane_id(); fr = l_ & 15; fq = l_ >> 4; }
        const bool lat = u.pm < NLAT / 256;
        const int mr = lat ? (u.pm >> 3) : 8;
        const float* gate = mod + mr * 6144 + 2048;
#pragma unroll
        for (int bj = 0; bj < 2; ++bj) {
            const int col = u.pn * 256 + bj * 128 + wc * 32 + 8 * fq;
            const f32x4 g0 = *(const f32x4*)(gate + col), g1 = *(const f32x4*)(gate + col + 4);
#pragma unroll
            for (int ai = 0; ai < 2; ++ai) { if (ai && u.hf) continue;
#pragma unroll
                for (int m = 0; m < 4; ++m) {
                    const int row = u.pm * 256 + (u.hf == 2 ? 128 : 0) + ai * 128 + wr * 64 + m * 16 + fr;
                    float v[8]; ACC8(v, acc, ai, bj, m);
                    float ho[8];
                    if (IN_F32) { const float* hp = lat ? xlat + (size_t)row * DM + col : xctx + (size_t)(row - NLAT) * DM + col;
                        const f32x4 a = *(const f32x4*)hp, b = *(const f32x4*)(hp + 4); ho[0] = a[0]; ho[1] = a[1]; ho[2] = a[2]; ho[3] = a[3]; ho[4] = b[0]; ho[5] = b[1]; ho[6] = b[2]; ho[7] = b[3]; }
                    else { const u32x4 w = *(const u32x4*)(hin + (size_t)row * DM + col); ho[0] = bflo(w.x); ho[1] = bfhi(w.x); ho[2] = bflo(w.y); ho[3] = bfhi(w.y); ho[4] = bflo(w.z); ho[5] = bfhi(w.z); ho[6] = bflo(w.w); ho[7] = bfhi(w.w); }
#pragma unroll
                    for (int i = 0; i < 4; ++i) { v[i] = ho[i] + g0[i] * v[i]; v[4 + i] = ho[4 + i] + g1[i] * v[4 + i]; }
                    store8(hout + (size_t)row * DM + col, v);
                } }
        }
    }
};
struct EpiInProj1 {
    static constexpr bool PERM = true;
    bf16* P1; const f32x2* R64;
    __device__ __forceinline__ void operator()(AccRef acc, const pg8::Unit& u, int wr, int wc, int fr, int fq) const {
        { const int l_ = lane_id(); fr = l_ & 15; fq = l_ >> 4; }
        const bool lat = u.pm < NLAT / 256;
#pragma unroll
        for (int bj = 0; bj < 2; ++bj) {
            const int col0 = u.pn * 256 + bj * 128 + wc * 32 + 8 * fq;
            const int cg = __builtin_amdgcn_readfirstlane(col0 >> 5);
            const bool rp = lat && ((cg % 12) < 8);
#pragma unroll
            for (int ai = 0; ai < 2; ++ai) { if (ai && u.hf) continue;
#pragma unroll
                for (int m = 0; m < 4; ++m) {
                    const int row = u.pm * 256 + (u.hf == 2 ? 128 : 0) + ai * 128 + wr * 64 + m * 16 + fr; const int t = row & (SEQ - 1);
                    float v[8]; ACC8(v, acc, ai, bj, m);
                    if (rp) rope8(v, R64 + t * 32 + ((col0 & 63) >> 1));
                    if ((cg % 12) < 4) {
#pragma unroll
                        for (int i = 0; i < 8; ++i) v[i] *= QSC_D64; }
                    store8(P1 + (size_t)row * 3072 + col0, v);
                } }
        }
    }
};
struct EpiGemm1 {
    static constexpr bool PERM = true;
    bf16* H;
    __device__ __forceinline__ void operator()(AccRef acc, const pg8::Unit& u, int wr, int wc, int fr, int fq) const {
        { const int l_ = lane_id(); fr = l_ & 15; fq = l_ >> 4; }
        const int pnl = u.pn & 1;
#pragma unroll
        for (int bj = 0; bj < 2; ++bj) {
            const int hc = pnl * 128 + bj * 64 + wc * 16 + 4 * fq;
#pragma unroll
            for (int ai = 0; ai < 2; ++ai)
#pragma unroll
                for (int m = 0; m < 4; ++m) {
                    const int row = u.pm * 256 + ai * 128 + wr * 64 + m * 16 + fr;
                    float v[8]; ACC8(v, acc, ai, bj, m); float h[4];
#pragma unroll
                    for (int i = 0; i < 4; ++i) { const float gg = v[2 * i]; h[i] = gg * __builtin_amdgcn_rcpf(1.f + __expf(-gg)) * v[2 * i + 1]; }
                    u32x2 w; w.x = cvt_pk_bf16(h[0], h[1]); w.y = cvt_pk_bf16(h[2], h[3]);
                    *(u32x2*)(H + (size_t)row * FF + hc) = w;
                }
        }
    }
};
struct EpiGemm2 {
    static constexpr bool PERM = true, WIDE = true;
    unsigned char* Yc; const int* list; const float* w8; const LAS int* cnt; float* hlat; float* hctx; const float* mod; bool dry; bf16* Hdbg; float* YS; LAS float* am;
    __device__ __forceinline__ void operator()(AccRef acc, const pg8::Unit& u, int wr, int wc, int fr, int fq) const {
        { const int l_ = lane_id(); fr = l_ & 15; fq = l_ >> 4; }
        const int pnl = u.pn & 3;
        {
            int dest[8];
#pragma unroll
            for (int q = 0; q < 8; ++q) dest[q] = u.pm * 256 + (q >> 2) * 128 + wr * 64 + (q & 3) * 16 + fr;
            float rm[8];
#pragma unroll
            for (int q = 0; q < 8; ++q) { const int ai = q >> 2, m = q & 3; float va[8], vb[8]; ACC8(va, acc, ai, 0, m); ACC8(vb, acc, ai, 1, m);
                float a = 0.f;
#pragma unroll
                for (int i = 0; i < 8; ++i) asm("v_max3_f32 %0, |%1|, |%2|, %3" : "=v"(a) : "v"(va[i]), "v"(vb[i]), "v"(a));
                rm[q] = a; }
            float r1[8];
#pragma unroll
            for (int q = 0; q < 8; ++q) r1[q] = __shfl_xor(rm[q], 16);
#pragma unroll
            for (int q = 0; q < 8; ++q) rm[q] = fmaxf(rm[q], r1[q]);
#pragma unroll
            for (int q = 0; q < 8; ++q) r1[q] = __shfl_xor(rm[q], 32);
#pragma unroll
            for (int q = 0; q < 8; ++q) rm[q] = fmaxf(rm[q], r1[q]);
            if (fq == 0) {
#pragma unroll
                for (int q = 0; q < 8; ++q) am[((q >> 2) * 128 + wr * 64 + (q & 3) * 16 + fr) * 4 + wc] = rm[q]; }
            __syncthreads();
#pragma unroll
            for (int q = 0; q < 8; ++q) { const f32x4 a4 = *(const LAS f32x4*)(am + ((q >> 2) * 128 + wr * 64 + (q & 3) * 16 + fr) * 4); rm[q] = fmaxf(fmaxf(a4[0], a4[1]), fmaxf(a4[2], a4[3])); }
            const bool odd = (fq & 1) != 0; const int boff = pnl * 256 + wc * 64 + (odd ? 32 + 8 * (fq - 1) : 8 * fq);
            unsigned pkp[4] = {0u, 0u, 0u, 0u}, rxp[2] = {0u, 0u};
#pragma unroll
            for (int q = 0; q < 9; ++q) {
                unsigned pk[4] = {0u, 0u, 0u, 0u}, rx[2] = {0u, 0u};
                if (q < 8) {
                    const int ai = q >> 2, m = q & 3; const float amx = rm[q]; const float sw = amx > 0.f ? 127.f * __builtin_amdgcn_rcpf(amx) : 0.f;
                    float va[8], vb[8]; ACC8(va, acc, ai, 0, m); ACC8(vb, acc, ai, 1, m);
                    unsigned ya[8], yb[8];
#pragma unroll
                    for (int i = 0; i < 8; ++i) { ya[i] = __float_as_uint(fmaf(va[i], sw, 12583040.f)); yb[i] = __float_as_uint(fmaf(vb[i], sw, 12583040.f)); }
                    pk[0] = (__builtin_amdgcn_perm(ya[3], ya[2], 0x0c0c0400u) << 16) | __builtin_amdgcn_perm(ya[1], ya[0], 0x0c0c0400u);
                    pk[1] = (__builtin_amdgcn_perm(ya[7], ya[6], 0x0c0c0400u) << 16) | __builtin_amdgcn_perm(ya[5], ya[4], 0x0c0c0400u);
                    pk[2] = (__builtin_amdgcn_perm(yb[3], yb[2], 0x0c0c0400u) << 16) | __builtin_amdgcn_perm(yb[1], yb[0], 0x0c0c0400u);
                    pk[3] = (__builtin_amdgcn_perm(yb[7], yb[6], 0x0c0c0400u) << 16) | __builtin_amdgcn_perm(yb[5], yb[4], 0x0c0c0400u);
                    rx[0] = __shfl_xor(odd ? pk[0] : pk[2], 16); rx[1] = __shfl_xor(odd ? pk[1] : pk[3], 16);
                }
                if (q > 0) {
                    const u32x4 x = odd ? (u32x4){rxp[0], rxp[1], pkp[2], pkp[3]} : (u32x4){pkp[0], pkp[1], rxp[0], rxp[1]};
                    const int d = dest[q - 1];
                    store16_wt(Yc + (size_t)d * DM + boff, x);
                    if (wc == 0 && fq == 0) YS[(size_t)d * 4 + pnl] = rm[q - 1] * (1.f / 127.f);
                }
#pragma unroll
                for (int i = 0; i < 4; ++i) pkp[i] = pk[i];
                rxp[0] = rx[0]; rxp[1] = rx[1];
                __builtin_amdgcn_sched_barrier(0);
            }
        }
    }
};
struct SchedMoe {
    const LAS int* pfx; const LAS int* cnt; const int* list; int NPN, G, c; int oneT; const LAS int* tab;
    __device__ __forceinline__ bool next(int i, pg8::Unit& u) const {
        if (tab == nullptr) return calc(i, u);
        if (i >= 64) return false;
        const pg8::u32x4 t = *(const LAS pg8::u32x4*)(tab + 4 * i);
        const int pm = __builtin_amdgcn_readfirstlane((int)t.x); if (pm < 0) return false;
        u.pm = pm; u.pn = __builtin_amdgcn_readfirstlane((int)t.y); u.e = __builtin_amdgcn_readfirstlane((int)t.z); u.r = __builtin_amdgcn_readfirstlane((int)t.w); u.hf = 0; return true;
    }
    __device__ __forceinline__ void build(LAS int* tb, int wave) const {
        if (wave == 0) { const int i = lane_id(); pg8::Unit u; const bool ok = calc(i, u);
            *(LAS pg8::u32x4*)(tb + 4 * i) = (pg8::u32x4){(unsigned)(ok ? u.pm : -1), (unsigned)u.pn, (unsigned)u.e, (unsigned)u.r}; }
        __syncthreads();
    }
    __device__ __forceinline__ bool calc(int i, pg8::Unit& u) const {
        const int total = pfx[65]; int T, pnl; u.pm = 0; u.pn = 0; u.e = 0; u.r = 0; u.hf = 0;
        if (oneT >= 0) { if (i >= NPN) return false; T = oneT; pnl = i; }
        else if (false && (G & 7) == 0 && ((G >> 3) % NPN) == 0) {
            const int x = c & 7, j = c >> 3, Gx = G >> 3, Tc = (total + 7) >> 3, Lx = i * Gx + j, Tl = Lx / NPN;
            pnl = Lx % NPN; T = x * Tc + Tl; if (Tl >= Tc || T >= total) return false;
        } else { const int L = i * G + c; if (L >= total * NPN) return false; T = L / NPN; pnl = L % NPN; }
        int lo = 0, hi = 64;
        while (lo < hi) { const int mid = (lo + hi + 1) >> 1; if (pfx[mid] <= T) lo = mid; else hi = mid - 1; }
        u.e = lo; u.r = T - pfx[lo]; u.pm = oneT >= 0 ? c : T; u.pn = lo * NPN + pnl; u.hf = 0; return true;
    }
    __device__ __forceinline__ unsigned row_off(const pg8::Unit& u, int row) const {
        int tok;
        if (u.e >= NEXP) tok = u.r * 256 + row;
        else { const int n = cnt[u.e]; int idx = u.r * 256 + row; idx = idx < n ? idx : n - 1; tok = list[(size_t)u.e * NT + idx] >> 3; }
        return (unsigned)tok * (unsigned)(DM * 2);
    }
};

namespace att {
struct Unit {
    const bf16* Q; int ldq;
    const bf16* K1; int ldk1;
    const bf16* K2; int ldk2;
    const bf16* V; int ldv;
    bf16* O; int ldo;
    int seg0_row, seg0_tiles, seg1_row, seg1_tiles;
    int qpos0, seg1_pos0;
    float sink;
};
__device__ __forceinline__ int crow(int r, int hi) { return (r & 3) + 8 * (r >> 2) + 4 * hi; }
typedef short v4i16_t __attribute__((ext_vector_type(4)));
__device__ __forceinline__ s16x4 vtr(const LAS unsigned char* p) { return __builtin_bit_cast(s16x4, __builtin_amdgcn_ds_read_tr16_b64_v4i16((LAS v4i16_t*)p)); }

#define ATT_SBAR() __builtin_amdgcn_sched_barrier(0)
constexpr float ATT_THR = 8.f;
template <bool MASK>
__device__ __forceinline__ void partialSM(f32x16& p0, f32x16& p1, float& m_reg, float& alpha, const float C, const float thr_raw, const bool domask, const int kbase, const int hi) {
    if (MASK) { if (domask) {
#pragma unroll
        for (int r = 0; r < 16; ++r) { const int d0 = kbase + crow(r, hi), d1 = d0 + 32;
            if (d0 > 128 || d0 < -128) p0[r] = -1e30f; if (d1 > 128 || d1 < -128) p1[r] = -1e30f; } } }
    float pmax = p0[0];
#pragma unroll
    for (int r = 1; r < 16; ++r) pmax = fmaxf(pmax, p0[r]);
#pragma unroll
    for (int r = 0; r < 16; ++r) pmax = fmaxf(pmax, p1[r]);
    { auto rr = __builtin_amdgcn_permlane32_swap(__float_as_uint(pmax), __float_as_uint(pmax), false, false); pmax = fmaxf(__uint_as_float(rr[0]), __uint_as_float(rr[1])); }
    float mn;
    if (__builtin_expect(__all(pmax - m_reg <= thr_raw), 1)) { mn = m_reg; alpha = 1.f; }
    else { mn = fmaxf(m_reg, pmax); alpha = __builtin_amdgcn_exp2f((m_reg - mn) * C); m_reg = mn; }
    const float mnC = -mn * C;
#pragma unroll
    for (int r = 0; r < 16; ++r) { p0[r] = fmaf(p0[r], C, mnC); p1[r] = fmaf(p1[r], C, mnC); }
#pragma unroll
    for (int r = 0; r < 16; ++r) p0[r] = __builtin_amdgcn_exp2f(p0[r]);
}
__device__ __forceinline__ void finishSM(f32x16& p0, f32x16& p1, const float alpha, float& l_reg, u32x4 (&pw)[4]) {
#pragma unroll
    for (int r = 0; r < 16; ++r) p1[r] = __builtin_amdgcn_exp2f(p1[r]);
    float ps = 0.f;
#pragma unroll
    for (int r = 0; r < 16; ++r) ps += p0[r] + p1[r];
    { auto rr = __builtin_amdgcn_permlane32_swap(__float_as_uint(ps), __float_as_uint(ps), false, false); ps = __uint_as_float(rr[0]) + __uint_as_float(rr[1]); }
    l_reg = l_reg * alpha + ps;
#pragma unroll
    for (int s = 0; s < 2; ++s) {
        pw[s] = (u32x4){cvt_pk_bf16(p0[8 * s], p0[8 * s + 1]), cvt_pk_bf16(p0[8 * s + 2], p0[8 * s + 3]), cvt_pk_bf16(p0[8 * s + 4], p0[8 * s + 5]), cvt_pk_bf16(p0[8 * s + 6], p0[8 * s + 7])};
        pw[2 + s] = (u32x4){cvt_pk_bf16(p1[8 * s], p1[8 * s + 1]), cvt_pk_bf16(p1[8 * s + 2], p1[8 * s + 3]), cvt_pk_bf16(p1[8 * s + 4], p1[8 * s + 5]), cvt_pk_bf16(p1[8 * s + 6], p1[8 * s + 7])};
    }
}
template <int DQK, int NC1, int DV, bool MASK, bool SINK>
__device__ __forceinline__ void unit(const Unit& u, const float scale, LAS unsigned char* lds, const int wid) {
    constexpr int NCH = DQK / 8, NVC = DV / 8, NQ = DQK / 16, ND = DV / 32;
    constexpr int KBYTES = NCH * 1040, VBYTES = ND * 4096;
    constexpr int KPT = (64 * NCH + 511) / 512, VPT = (64 * NVC) / 512;
    constexpr int V_OFF = 2 * KBYTES, WS_OFF = V_OFF + 3 * VBYTES;
    const int lane = lane_id(), tid = wid * 64 + lane, r32 = lane & 31, hi = lane >> 5;
    LAS float* wsf = (LAS float*)(lds + WS_OFF) + wid * 64;
    const float C = scale * 1.4426950408889634f; const float thr_raw = ATT_THR / scale;
    bf16x8 qr[NQ];
    { const bf16* qp = u.Q + (size_t)(wid * 32 + r32) * u.ldq + hi * 8;
#pragma unroll
      for (int c = 0; c < NQ; ++c) qr[c] = *(const bf16x8*)(qp + c * 16); }
    float m_reg = SINK ? u.sink / scale : -1e30f, l_reg = SINK ? 1.f : 0.f;
    f32x16 o[ND];
#pragma unroll
    for (int d = 0; d < ND; ++d) o[d] = (f32x16){};
    int kkey[KPT], kch[KPT]; bool kact[KPT]; int vkey[VPT], vch[VPT];
#pragma unroll
    for (int i = 0; i < KPT; ++i) { const int q = tid + 512 * i; kact[i] = q < 64 * NCH; const int qq = kact[i] ? q : 0; kkey[i] = qq / NCH; kch[i] = qq % NCH; }
#pragma unroll
    for (int i = 0; i < VPT; ++i) { const int q = tid + 512 * i; vkey[i] = q / NVC; vch[i] = q % NVC; }
    u32x4 ks[KPT], vs[VPT];
    const int NTILES = u.seg0_tiles + u.seg1_tiles;
#define ATT_KROW(j) ((j) < u.seg0_tiles ? u.seg0_row + 64 * (j) : u.seg1_row + 64 * ((j) - u.seg0_tiles))
#define ATT_GLOAD(j) do { const int kr0_ = ATT_KROW(j); \
      _Pragma("unroll") for (int i_ = 0; i_ < KPT; ++i_) { if (kact[i_]) { const size_t row_ = (size_t)(kr0_ + kkey[i_]); \
          const bf16* src_ = (kch[i_] < NC1) ? u.K1 + row_ * u.ldk1 + kch[i_] * 8 : u.K2 + row_ * u.ldk2 + (kch[i_] - NC1) * 8; ks[i_] = *(const u32x4*)src_; } } \
      _Pragma("unroll") for (int i_ = 0; i_ < VPT; ++i_) { vs[i_] = *(const u32x4*)(u.V + (size_t)(kr0_ + vkey[i_]) * u.ldv + vch[i_] * 8); } } while (0)
#define ATT_SWRITE(kb_i, vb_i) do { LAS unsigned char* kb_ = lds + (kb_i) * KBYTES; LAS unsigned char* vb_ = lds + V_OFF + (vb_i) * VBYTES; \
      _Pragma("unroll") for (int i_ = 0; i_ < KPT; ++i_) { if (kact[i_]) *(LAS u32x4*)(kb_ + kch[i_] * 1040 + kkey[i_] * 16) = ks[i_]; } \
      _Pragma("unroll") for (int i_ = 0; i_ < VPT; ++i_) { *(LAS u32x4*)(vb_ + (vch[i_] >> 2) * 4096 + vkey[i_] * 64 + (vch[i_] & 3) * 16) = vs[i_]; } } while (0)
#define ATT_QKT(P0, P1, kb_i) do { const LAS unsigned char* kq_ = lds + (kb_i) * KBYTES + koff; P0 = (f32x16){}; P1 = (f32x16){}; \
      _Pragma("unroll") for (int c_ = 0; c_ < NQ; ++c_) { const bf16x8 k0_ = *(const LAS bf16x8*)(kq_ + c_ * 2080), k1_ = *(const LAS bf16x8*)(kq_ + c_ * 2080 + 512); \
          P0 = __builtin_amdgcn_mfma_f32_32x32x16_bf16(k0_, qr[c_], P0, 0, 0, 0); P1 = __builtin_amdgcn_mfma_f32_32x32x16_bf16(k1_, qr[c_], P1, 0, 0, 0); } } while (0)
#define ATT_PV(vb_i) do { const LAS unsigned char* vp_ = lds + V_OFF + (vb_i) * VBYTES + voff; \
      _Pragma("unroll") for (int d_ = 0; d_ < ND; ++d_) _Pragma("unroll") for (int s_ = 0; s_ < 4; ++s_) { \
          const s16x4 lo_ = vtr(vp_ + d_ * 4096 + s_ * 1024), hh_ = vtr(vp_ + d_ * 4096 + s_ * 1024 + 512); \
          const bf16x8 vf_ = (bf16x8){lo_[0], lo_[1], lo_[2], lo_[3], hh_[0], hh_[1], hh_[2], hh_[3]}; \
          o[d_] = __builtin_amdgcn_mfma_f32_32x32x16_bf16(__builtin_bit_cast(bf16x8, pw[s_]), vf_, o[d_], 0, 0, 0); } } while (0)
#define ATT_RESC(al) do { if (__any((al) < 1.f)) { if (hi == 0) wsf[r32] = (al); asm volatile("s_waitcnt lgkmcnt(0)" ::: "memory"); \
      _Pragma("unroll") for (int r_ = 0; r_ < 16; ++r_) { const float a_ = wsf[crow(r_, hi)]; _Pragma("unroll") for (int d_ = 0; d_ < ND; ++d_) o[d_][r_] *= a_; } } } while (0)
#define ATT_MASKARGS(j) (MASK && (j) >= u.seg0_tiles), (u.seg1_pos0 + 64 * ((j) - u.seg0_tiles) - (u.qpos0 + wid * 32 + r32)), hi
    const int koff = hi * 1040 + r32 * 16;
    const int voff = ((lane >> 4) & 1) * 32 + (lane & 3) * 8 + (4 * hi + ((lane & 15) >> 2)) * 64;
    ATT_GLOAD(0); ATT_SWRITE(0, 0);
    if (1 < NTILES) { ATT_GLOAD(1); ATT_SWRITE(1, 1); }
    __syncthreads();
    f32x16 pA0, pA1, pB0, pB1; float alA, alB = 1.f; u32x4 pw[4];
    ATT_QKT(pA0, pA1, 0); partialSM<MASK>(pA0, pA1, m_reg, alA, C, thr_raw, ATT_MASKARGS(0));
    ATT_RESC(alA);
    __syncthreads();
    int vcur = 0;
#define ATT_STEP(j, C0, C1, alC, N0, N1, alN) do { const int j_ = (j); const bool hasN_ = j_ + 1 < NTILES, has2_ = j_ + 2 < NTILES; \
      ATT_SBAR(); if (hasN_) ATT_QKT(N0, N1, (j_ + 1) & 1); finishSM(C0, C1, alC, l_reg, pw); ATT_SBAR(); \
      if (has2_) ATT_GLOAD(j_ + 2); ATT_SBAR(); \
      ATT_PV(vcur); if (hasN_) partialSM<MASK>(N0, N1, m_reg, alN, C, thr_raw, ATT_MASKARGS(j_ + 1)); \
      const int v2_ = vcur == 0 ? 2 : vcur - 1;          \
      if (has2_) ATT_SWRITE(j_ & 1, v2_); \
      if (hasN_) ATT_RESC(alN); \
      __syncthreads(); vcur = vcur == 2 ? 0 : vcur + 1; } while (0)
    for (int j = 0; j < NTILES; j += 2) {
        ATT_STEP(j, pA0, pA1, alA, pB0, pB1, alB);
        if (j + 1 < NTILES) ATT_STEP(j + 1, pB0, pB1, alB, pA0, pA1, alA);
    }
    if (hi == 0) wsf[32 + r32] = l_reg;
    asm volatile("s_waitcnt lgkmcnt(0)" ::: "memory");
    bf16* Ow = u.O + (size_t)(wid * 32) * u.ldo;
#pragma unroll
    for (int r = 0; r < 16; ++r) { const int orow = crow(r, hi); const float rl = __builtin_amdgcn_rcpf(wsf[32 + orow]);
#pragma unroll
        for (int d = 0; d < ND; ++d) { const float v = o[d][r] * rl; Ow[(size_t)orow * u.ldo + d * 32 + r32] = (bf16)(cvt_pk_bf16(v, v) & 0xffffu); } }
    __syncthreads();
#undef ATT_KROW
#undef ATT_GLOAD
#undef ATT_SWRITE
#undef ATT_QKT
#undef ATT_PV
#undef ATT_RESC
#undef ATT_MASKARGS
#undef ATT_STEP
}

struct UnitD { const bf16* P; int ldp; int qcol, kcol, vcol; bf16* O; int ldo; int qrow0; int seg0_row, seg0_tiles, seg1_row, seg1_tiles; float lam, post; const float* gsub; };
__device__ __forceinline__ void unit_diff(const UnitD& u, const float scale, LAS unsigned char* lds, const int wid) {
    constexpr int NQ = 4, ND = 4, KBYTES = 8 * 1040, VBYTES = 4 * 4096;
    constexpr int V_OFF = 4 * KBYTES, WS_OFF = V_OFF + 3 * VBYTES;
    const int lane = lane_id(), tid = wid * 64 + lane, r32 = lane & 31, hi = lane >> 5; const int wsel = wid >> 2, wq = wid & 3;
    LAS float* wsf = (LAS float*)(lds + WS_OFF) + wid * 64;
    const float C = scale * 1.4426950408889634f; const float thr_raw = ATT_THR / scale;
    bf16x8 qr[NQ];
    { const bf16* qp = u.P + (size_t)(u.qrow0 + wq * 32 + r32) * u.ldp + u.qcol + wsel * 64 + hi * 8;
#pragma unroll
      for (int c = 0; c < NQ; ++c) qr[c] = *(const bf16x8*)(qp + c * 16); }
    float m_reg = -1e30f, l_reg = 0.f;
    f32x16 o[ND];
#pragma unroll
    for (int d = 0; d < ND; ++d) o[d] = (f32x16){};
    u32x4 ks[2], vs[2];
    const int NTILES = u.seg0_tiles + u.seg1_tiles;
#define ATD_KROW(j) ((j) < u.seg0_tiles ? u.seg0_row + 64 * (j) : u.seg1_row + 64 * ((j) - u.seg0_tiles))
#define ATD_GLOAD(j) do { const int kr0_ = ATD_KROW(j); \
      _Pragma("unroll") for (int i_ = 0; i_ < 2; ++i_) { const int q_ = tid + 512 * i_; \
          ks[i_] = *(const u32x4*)(u.P + (size_t)(kr0_ + ((q_ >> 3) & 63)) * u.ldp + u.kcol + (q_ >> 9) * 64 + (q_ & 7) * 8); \
          vs[i_] = *(const u32x4*)(u.P + (size_t)(kr0_ + (q_ >> 4)) * u.ldp + u.vcol + (q_ & 15) * 8); } } while (0)
#define ATD_SWRITE(kb_i, vb_i) do { LAS unsigned char* kb_ = lds + (kb_i) * 2 * KBYTES; LAS unsigned char* vb_ = lds + V_OFF + (vb_i) * VBYTES; \
      _Pragma("unroll") for (int i_ = 0; i_ < 2; ++i_) { const int q_ = tid + 512 * i_; \
          *(LAS u32x4*)(kb_ + (q_ >> 9) * KBYTES + (q_ & 7) * 1040 + ((q_ >> 3) & 63) * 16) = ks[i_]; \
          *(LAS u32x4*)(vb_ + ((q_ & 15) >> 2) * 4096 + (q_ >> 4) * 64 + (q_ & 3) * 16) = vs[i_]; } } while (0)
#define ATD_QKT(P0, P1, kb_i) do { const LAS unsigned char* kq_ = lds + ((kb_i) * 2 + wsel) * KBYTES + koff; P0 = (f32x16){}; P1 = (f32x16){}; \
      _Pragma("unroll") for (int c_ = 0; c_ < NQ; ++c_) { const bf16x8 k0_ = *(const LAS bf16x8*)(kq_ + c_ * 2080), k1_ = *(const LAS bf16x8*)(kq_ + c_ * 2080 + 512); \
          P0 = __builtin_amdgcn_mfma_f32_32x32x16_bf16(k0_, qr[c_], P0, 0, 0, 0); P1 = __builtin_amdgcn_mfma_f32_32x32x16_bf16(k1_, qr[c_], P1, 0, 0, 0); } } while (0)
#define ATD_PV(vb_i) do { const LAS unsigned char* vp_ = lds + V_OFF + (vb_i) * VBYTES + voff; \
      _Pragma("unroll") for (int d_ = 0; d_ < ND; ++d_) _Pragma("unroll") for (int s_ = 0; s_ < 4; ++s_) { \
          const s16x4 lo_ = vtr(vp_ + d_ * 4096 + s_ * 1024), hh_ = vtr(vp_ + d_ * 4096 + s_ * 1024 + 512); \
          const bf16x8 vf_ = (bf16x8){lo_[0], lo_[1], lo_[2], lo_[3], hh_[0], hh_[1], hh_[2], hh_[3]}; \
          o[d_] = __builtin_amdgcn_mfma_f32_32x32x16_bf16(__builtin_bit_cast(bf16x8, pw[s_]), vf_, o[d_], 0, 0, 0); } } while (0)
#define ATD_RESC(al) do { if (__any((al) < 1.f)) { if (hi == 0) wsf[r32] = (al); asm volatile("s_waitcnt lgkmcnt(0)" ::: "memory"); \
      _Pragma("unroll") for (int r_ = 0; r_ < 16; ++r_) { const float a_ = wsf[crow(r_, hi)]; _Pragma("unroll") for (int d_ = 0; d_ < ND; ++d_) o[d_][r_] *= a_; } } } while (0)
    const int koff = hi * 1040 + r32 * 16;
    const int voff = ((lane >> 4) & 1) * 32 + (lane & 3) * 8 + (4 * hi + ((lane & 15) >> 2)) * 64;
    ATD_GLOAD(0); ATD_SWRITE(0, 0);
    if (1 < NTILES) { ATD_GLOAD(1); ATD_SWRITE(1, 1); }
    __syncthreads();
    f32x16 pA0, pA1, pB0, pB1; float alA, alB = 1.f; u32x4 pw[4];
    ATD_QKT(pA0, pA1, 0); partialSM<false>(pA0, pA1, m_reg, alA, C, thr_raw, false, 0, hi);
    ATD_RESC(alA);
    __syncthreads();
    int vcur = 0;
#define ATD_STEP(j, C0, C1, alC, N0, N1, alN) do { const int j_ = (j); const bool hasN_ = j_ + 1 < NTILES, has2_ = j_ + 2 < NTILES; \
      ATT_SBAR(); if (hasN_) ATD_QKT(N0, N1, (j_ + 1) & 1); finishSM(C0, C1, alC, l_reg, pw); ATT_SBAR(); \
      if (has2_) ATD_GLOAD(j_ + 2); ATT_SBAR(); \
      ATD_PV(vcur); if (hasN_) partialSM<false>(N0, N1, m_reg, alN, C, thr_raw, false, 0, hi); \
      const int v2_ = vcur == 0 ? 2 : vcur - 1; \
      if (has2_) ATD_SWRITE(j_ & 1, v2_); \
      if (hasN_) ATD_RESC(alN); \
      __syncthreads(); vcur = vcur == 2 ? 0 : vcur + 1; } while (0)
    for (int j = 0; j < NTILES; j += 2) {
        ATD_STEP(j, pA0, pA1, alA, pB0, pB1, alB);
        if (j + 1 < NTILES) ATD_STEP(j + 1, pB0, pB1, alB, pA0, pA1, alA);
    }
    if (hi == 0) wsf[32 + r32] = l_reg;
    asm volatile("s_waitcnt lgkmcnt(0)" ::: "memory");
    float rl[16];
#pragma unroll
    for (int r = 0; r < 16; ++r) rl[r] = __builtin_amdgcn_rcpf(wsf[32 + crow(r, hi)]);
    LAS float* X = (LAS float*)lds + wq * 4096;
    if (wsel == 1) {
#pragma unroll
        for (int d = 0; d < ND; ++d)
#pragma unroll
            for (int r = 0; r < 16; ++r) X[(d * 16 + r) * 64 + lane] = o[d][r] * rl[r];
    }
    __syncthreads();
    if (wsel == 0) {
        float ss[16];
#pragma unroll
        for (int r = 0; r < 16; ++r) { float s = 0.f;
#pragma unroll
            for (int d = 0; d < ND; ++d) { const float v = o[d][r] * rl[r] - u.lam * X[(d * 16 + r) * 64 + lane]; o[d][r] = v; s += v * v; }
            ss[r] = s; }
#pragma unroll
        for (int r = 0; r < 16; ++r) { float s = ss[r]; s += __shfl_xor(s, 1); s += __shfl_xor(s, 2); s += __shfl_xor(s, 4); s += __shfl_xor(s, 8); s += __shfl_xor(s, 16); ss[r] = rsqrtf(s * (1.f / 128.f) + EPS) * u.post; }
        bf16* Ow = u.O + (size_t)(u.qrow0 + wq * 32) * u.ldo;
#pragma unroll
        for (int d = 0; d < ND; ++d) { const float g = u.gsub[d * 32 + r32];
#pragma unroll
            for (int r = 0; r < 16; ++r) { const float v = o[d][r] * ss[r] * g; Ow[(size_t)crow(r, hi) * u.ldo + d * 32 + r32] = (bf16)(cvt_pk_bf16(v, v) & 0xffffu); } }
    }
    __syncthreads();
#undef ATD_KROW
#undef ATD_GLOAD
#undef ATD_SWRITE
#undef ATD_QKT
#undef ATD_PV
#undef ATD_RESC
#undef ATD_STEP
}
struct UnitH {
    const bf16* Q; int ldq;
    const bf16* K1; int ldk1;
    const bf16* K2; int ldk2;
    const bf16* V; int ldv;
    bf16* O; int ldo;
    int seg0_row, seg0_tiles, seg1_row, seg1_tiles;
    int qpos0, seg1_pos0;
    float sinkl;
    float lam, post; const float* gsub;
};
__device__ __forceinline__ void glds16s(const void* sbase, unsigned voff, unsigned lds_dst) { unsigned keep;
    asm volatile("s_mov_b32 %0, m0\n\ts_mov_b32 m0, %3\n\ts_nop 0\n\tglobal_load_lds_dwordx4 %1, %2\n\ts_mov_b32 m0, %0" : "=&s"(keep) : "v"(voff), "s"(sbase), "s"(lds_dst) : "memory"); }
typedef float f32x2_t __attribute__((ext_vector_type(2))); typedef __bf16 bf16x2_t __attribute__((ext_vector_type(2)));
__device__ __forceinline__ unsigned cvtpk_s(float lo, float hi) { f32x2_t v = {lo, hi}; bf16x2_t b = __builtin_convertvector(v, bf16x2_t); return __builtin_bit_cast(unsigned, b); }
template <int N> __device__ __forceinline__ void wait_bar() { asm volatile("s_waitcnt vmcnt(%0) lgkmcnt(0)\n\ts_barrier" :: "n"(N) : "memory"); }
#define HI_SBAR() __builtin_amdgcn_sched_barrier(0)
#define HI_PIN(x) asm volatile("" : "+v"(x))
#define HI_MFMA(a, b, c) __builtin_amdgcn_mfma_f32_32x32x16_bf16((a), (b), (c), 0, 0, 0)
#define HI_MX3(a, b, c) __builtin_fmaxf(__builtin_fmaxf((a), (b)), (c))
#define HI_EX(v) __builtin_amdgcn_exp2f(v)

template <int NQ, int ND, bool MASK, bool SINK, bool DIFF>
__device__ __forceinline__ void unit_hi(const UnitH& u, LAS unsigned char* lds, const int wid) {
    constexpr int THRL = 8;
    constexpr int NCH = 2 * NQ;
    constexpr int KSLOT = (DIFF ? 2 : 1) * NCH * 1024, VSLOT = ND * 4096;
    constexpr int V_OFF = 3 * KSLOT, WS_OFF = V_OFF + 3 * VSLOT;
    constexpr int NKP = DIFF ? 2 : 1, KX = (!DIFF && NCH > 8) ? 1 : 0, NVP = ND / 2;
    constexpr int NF = 4 * ND;
    constexpr int VA = 8, VA0 = 2 * NQ - 8;
    constexpr int KG0 = ND == 2 ? (NQ == 4 ? 2 : 1) : 8, KGS = ND == 2 ? 1 : 2;
    constexpr int NE = 32 / NF;
    const int lane = lane_id(), r32 = lane & 31, hi = lane >> 5;
    const int wsel = DIFF ? (wid >> 2) : 0, wq = DIFF ? (wid & 3) : wid;
    const bool kx = KX && wid < 4;
    LAS float* wsf = (LAS float*)(lds + WS_OFF) + wid * 64;
    const unsigned ldsb = (unsigned)(size_t)lds;
    const unsigned kvoff = (unsigned)(lane * u.ldk1 + wid * 8) * 2u, kxoff = (unsigned)(lane * u.ldk2 + (wid & 3) * 8) * 2u;
    const unsigned vvoff = (unsigned)((16 * (wid & 3) + (lane >> 2)) * u.ldv + (wid >> 2) * 32 + (lane & 3) * 8) * 2u;
#define HI_KROW(j) ((j) < u.seg0_tiles ? u.seg0_row + 64 * (j) : u.seg1_row + 64 * ((j) - u.seg0_tiles))
#define HI_DMA_K(t, slot) do { const size_t r_ = (size_t)HI_KROW(t); const unsigned d_ = (unsigned)__builtin_amdgcn_readfirstlane((int)(ldsb + (slot) * KSLOT + wid * 1024)); \
      glds16s(u.K1 + r_ * u.ldk1, kvoff, d_); if (DIFF) glds16s(u.K1 + r_ * u.ldk1 + 64, kvoff, d_ + 8192); \
      if (KX) { if (kx) glds16s(u.K2 + r_ * u.ldk2, kxoff, d_ + 8192); } } while (0)
#define HI_DMA_V(t, slot) do { const size_t r_ = (size_t)HI_KROW(t); const unsigned d_ = (unsigned)__builtin_amdgcn_readfirstlane((int)(ldsb + V_OFF + (slot) * VSLOT + wid * 1024)); \
      glds16s(u.V + r_ * u.ldv, vvoff, d_); if (ND == 4) glds16s(u.V + r_ * u.ldv + 64, vvoff, d_ + 8192); } while (0)
#define HI_WAITB(nk, nv) do { if (KX && kx) wait_bar<(nk) * (NKP + 1) + (nv) * NVP>(); else wait_bar<(nk) * NKP + (nv) * NVP>(); } while (0)
    const LAS unsigned char* kp0 = lds + wsel * (NCH * 1024) + hi * 1024 + r32 * 16;
    const LAS unsigned char* vp0 = lds + V_OFF + ((lane >> 4) & 1) * 32 + (lane & 3) * 8 + (4 * hi + ((lane & 15) >> 2)) * 64;
    const int NT = u.seg0_tiles + u.seg1_tiles;
    HI_DMA_K(0, 0); HI_DMA_V(0, 0); HI_DMA_K(1, 1);
    bf16x8 qr[NQ];
    { const bf16* qp = u.Q + (size_t)(wq * 32 + r32) * u.ldq + wsel * 64 + hi * 8;
#pragma unroll
      for (int c = 0; c < NQ; ++c) qr[c] = *(const bf16x8*)(qp + c * 16); }
    float mhat = SINK ? u.sinkl : 0.f, l_reg = (SINK && hi == 0) ? 1.f : 0.f;
    f32x16 o[ND];
#pragma unroll
    for (int d = 0; d < ND; ++d) o[d] = (f32x16){};
    f32x16 negm;
#pragma unroll
    for (int r = 0; r < 16; ++r) negm[r] = -mhat;
    HI_PIN(negm);
    const int qrel = u.qpos0 + wq * 32 + r32;
#define HI_MASK(C0, C1, t) do { if (MASK) { if ((t) >= u.seg0_tiles) { const int kb_ = u.seg1_pos0 + 64 * ((t) - u.seg0_tiles) - qrel; \
      _Pragma("unroll") for (int r = 0; r < 16; ++r) { const int d0_ = kb_ + crow(r, hi), d1_ = d0_ + 32; \
          if (d0_ > 128 || d0_ < -128) C0[r] = -1e30f; if (d1_ > 128 || d1_ < -128) C1[r] = -1e30f; } } } } while (0)
#define HI_ROWMAX(rm, C0, C1) do { float a_ = HI_MX3(C0[0], C0[1], C1[0]), b_ = HI_MX3(C0[2], C0[3], C1[1]); a_ = HI_MX3(a_, C1[2], C1[3]); \
      _Pragma("unroll") for (int r = 4; r < 16; r += 4) { a_ = HI_MX3(a_, C0[r], C0[r + 1]); b_ = HI_MX3(b_, C0[r + 2], C0[r + 3]); a_ = HI_MX3(a_, C1[r], C1[r + 1]); b_ = HI_MX3(b_, C1[r + 2], C1[r + 3]); } \
      rm = __builtin_fmaxf(a_, b_); { auto rr_ = __builtin_amdgcn_permlane32_swap(__float_as_uint(rm), __float_as_uint(rm), false, false); rm = __builtin_fmaxf(__uint_as_float(rr_[0]), __uint_as_float(rr_[1])); } } while (0)
    bool resc = false;
#define HI_DECIDE(C0, C1) do { float rm_; HI_ROWMAX(rm_, C0, C1); resc = false; \
      if (__builtin_expect(__any(rm_ > (float)THRL), 0)) { const float dl_ = __builtin_fmaxf(rm_, 0.f); mhat += dl_; \
          _Pragma("unroll") for (int r = 0; r < 16; ++r) { C0[r] -= dl_; C1[r] -= dl_; } \
          _Pragma("unroll") for (int r = 0; r < 16; ++r) negm[r] = -mhat; HI_PIN(negm); \
          const float f_ = HI_EX(-dl_); l_reg *= f_; if (hi == 0) wsf[r32] = f_; resc = true; } } while (0)
#define HI_RESC() do { if (resc) { asm volatile("s_waitcnt lgkmcnt(0)" ::: "memory"); \
      _Pragma("unroll") for (int r = 0; r < 16; ++r) { const float a_ = wsf[crow(r, hi)]; _Pragma("unroll") for (int d_ = 0; d_ < ND; ++d_) o[d_][r] *= a_; } } } while (0)
    f32x16 pA0, pA1, pB0, pB1;
    int sl_prev = 0, sl_cur = 0, sl_next = 1;
#define HI_ROT() do { sl_prev = sl_cur; sl_cur = sl_next; sl_next = sl_next == 2 ? 0 : sl_next + 1; } while (0)
    HI_DMA_K(2, 2);
    HI_WAITB(2, 1);
    { const LAS unsigned char* kq_ = kp0;
#pragma unroll
      for (int c = 0; c < NQ; ++c) { const bf16x8 k0_ = *(const LAS bf16x8*)(kq_ + c * 2048), k1_ = *(const LAS bf16x8*)(kq_ + c * 2048 + 512);
          pA0 = HI_MFMA(k0_, qr[c], c == 0 ? negm : pA0); pA1 = HI_MFMA(k1_, qr[c], c == 0 ? negm : pA1); } }
    HI_MASK(pA0, pA1, 0);
    if (SINK) { HI_DECIDE(pA0, pA1); }
    else { float rm_; HI_ROWMAX(rm_, pA0, pA1); mhat += rm_;
#pragma unroll
        for (int r = 0; r < 16; ++r) { pA0[r] -= rm_; pA1[r] -= rm_; }
#pragma unroll
        for (int r = 0; r < 16; ++r) negm[r] = -mhat;
        HI_PIN(negm); }
#pragma unroll
    for (int r = 0; r < 16; ++r) { pA0[r] = HI_EX(pA0[r]); pA1[r] = HI_EX(pA1[r]); }
    wait_bar<0>();
    HI_DMA_K(3, 0); HI_DMA_V(1, 1);
    HI_ROT();
    bf16x8 kf[2 * NQ];
    { const LAS unsigned char* kq_ = kp0 + sl_cur * KSLOT;
#pragma unroll
      for (int c = 0; c < NQ; ++c) { kf[2 * c] = *(const LAS bf16x8*)(kq_ + c * 2048); kf[2 * c + 1] = *(const LAS bf16x8*)(kq_ + c * 2048 + 512); } }
    HI_WAITB(1, 1);
    s16x4 vlo[NF], vhi[NF]; u32x4 pw[4];
#define HI_PE(P0, P1, e) ((e) < 16 ? P0[(e) & 15] : P1[(e) & 15])
#define HI_VRD(f) do { vlo[f] = vtr(vp_ + (((f) % ND) * 4096 + ((f) / ND) * 1024)); vhi[f] = vtr(vp_ + (((f) % ND) * 4096 + ((f) / ND) * 1024 + 512)); } while (0)
#define HI_VFR(f) __builtin_shufflevector(vlo[f], vhi[f], 0, 1, 2, 3, 4, 5, 6, 7)
#define HI_STEP(C0, C1, P0, P1, t, GK, GV, GL) do { HI_SBAR(); \
      const LAS unsigned char* vp_ = vp0 + sl_prev * VSLOT; const LAS unsigned char* kn_ = kp0 + sl_next * KSLOT; \
      float sacc = 0.f; \
      _Pragma("unroll") for (int g = 0; g < 2 * NQ; ++g) { \
          if (g >= VA0 && g - VA0 < VA) { HI_VRD(g - VA0); HI_SBAR(); } \
          if (g & 1) C1 = HI_MFMA(kf[g], qr[g >> 1], g < 2 ? negm : C1); else C0 = HI_MFMA(kf[g], qr[g >> 1], g < 2 ? negm : C0); \
          if (g < 8) { sacc += HI_PE(P0, P1, 4 * g); sacc += HI_PE(P0, P1, 4 * g + 1); sacc += HI_PE(P0, P1, 4 * g + 2); sacc += HI_PE(P0, P1, 4 * g + 3); HI_PIN(sacc); \
              pw[g >> 1][(g & 1) * 2] = cvtpk_s(HI_PE(P0, P1, 4 * g), HI_PE(P0, P1, 4 * g + 1)); pw[g >> 1][(g & 1) * 2 + 1] = cvtpk_s(HI_PE(P0, P1, 4 * g + 2), HI_PE(P0, P1, 4 * g + 3)); HI_PIN(pw[g >> 1]); } \
          HI_SBAR(); } \
      l_reg += sacc; \
      if (GK) { HI_DMA_K((t) + 3, sl_cur); } if (GV) { HI_DMA_V((t) + 1, sl_next); } \
      HI_MASK(C0, C1, t); \
      HI_DECIDE(C0, C1); \
      HI_SBAR(); \
      _Pragma("unroll") for (int g = 0; g < NF; ++g) { \
          if (GL) { if (g >= KG0 && (g - KG0) % KGS == 0 && (g - KG0) / KGS < NQ) { const int j_ = (g - KG0) / KGS; \
              kf[2 * j_] = *(const LAS bf16x8*)(kn_ + j_ * 2048); kf[2 * j_ + 1] = *(const LAS bf16x8*)(kn_ + j_ * 2048 + 512); HI_SBAR(); } } \
          if (g + VA < NF) { HI_VRD(g + VA); HI_SBAR(); } \
          o[g % ND] = HI_MFMA(__builtin_bit_cast(bf16x8, pw[g / ND]), HI_VFR(g), o[g % ND]); \
          _Pragma("unroll") for (int e = NE * g; e < NE * g + NE; ++e) { if (e < 16) C0[e & 15] = HI_EX(C0[e & 15]); else C1[e & 15] = HI_EX(C1[e & 15]); } \
          if (NE * g < 16) HI_PIN(C0); else HI_PIN(C1); \
          HI_SBAR(); } \
    } while (0)
#define HI_ENDW(tt) do { if ((tt) + 3 < NT) { HI_WAITB(1, 1); } else if ((tt) + 2 < NT) { HI_WAITB(0, 1); } else { wait_bar<0>(); } } while (0)
    int t = 1;
    if (!MASK) {
        for (; t + 5 < NT; t += 2) {
#undef HI_MASK
#define HI_MASK(C0, C1, t) do { } while (0)
            HI_STEP(pB0, pB1, pA0, pA1, t, true, true, true);         HI_WAITB(1, 1); HI_RESC(); HI_ROT();
            HI_STEP(pA0, pA1, pB0, pB1, t + 1, true, true, true);     HI_WAITB(1, 1); HI_RESC(); HI_ROT();
        }
    }
#undef HI_MASK
#define HI_MASK(C0, C1, t) do { if (MASK) { if ((t) >= u.seg0_tiles) { const int kb_ = u.seg1_pos0 + 64 * ((t) - u.seg0_tiles) - qrel; \
      _Pragma("unroll") for (int r = 0; r < 16; ++r) { const int d0_ = kb_ + crow(r, hi), d1_ = d0_ + 32; \
          if (d0_ > 128 || d0_ < -128) C0[r] = -1e30f; if (d1_ > 128 || d1_ < -128) C1[r] = -1e30f; } } } } while (0)
    for (; t + 1 < NT; t += 2) {
        HI_STEP(pB0, pB1, pA0, pA1, t, (t + 3 < NT), (t + 1 < NT), (t + 1 < NT));          HI_ENDW(t);     HI_RESC(); HI_ROT();
        HI_STEP(pA0, pA1, pB0, pB1, t + 1, (t + 4 < NT), (t + 2 < NT), (t + 2 < NT));      HI_ENDW(t + 1); HI_RESC(); HI_ROT();
    }
    HI_STEP(pB0, pB1, pA0, pA1, NT - 1, false, false, false); HI_RESC();
    { float sacc = 0.f;
#pragma unroll
      for (int r = 0; r < 16; ++r) sacc += pB0[r] + pB1[r];
      l_reg += sacc;
#pragma unroll
      for (int k = 0; k < 4; ++k)
#pragma unroll
          for (int i = 0; i < 4; ++i) pw[k][i] = cvtpk_s(HI_PE(pB0, pB1, 8 * k + 2 * i), HI_PE(pB0, pB1, 8 * k + 2 * i + 1));
      const LAS unsigned char* vp_ = vp0 + sl_cur * VSLOT;
#pragma unroll
      for (int g = 0; g < NF; ++g) { HI_VRD(g); o[g % ND] = HI_MFMA(__builtin_bit_cast(bf16x8, pw[g / ND]), HI_VFR(g), o[g % ND]); } }
    { auto rr = __builtin_amdgcn_permlane32_swap(__float_as_uint(l_reg), __float_as_uint(l_reg), false, false); l_reg = __uint_as_float(rr[0]) + __uint_as_float(rr[1]); }
    if (hi == 0) wsf[32 + r32] = l_reg;
    asm volatile("s_waitcnt lgkmcnt(0)" ::: "memory");
    if (!DIFF) {
        bf16* Ow = u.O + (size_t)(wid * 32) * u.ldo;
#pragma unroll
        for (int r = 0; r < 16; ++r) { const int orow = crow(r, hi); const float rl = __builtin_amdgcn_rcpf(wsf[32 + orow]);
#pragma unroll
            for (int d = 0; d < ND; ++d) { const float v = o[d][r] * rl; Ow[(size_t)orow * u.ldo + d * 32 + r32] = (bf16)(cvtpk_s(v, v) & 0xffffu); } }
        asm volatile("s_waitcnt lgkmcnt(0)\n\ts_barrier" ::: "memory");
    } else {
        float rl[16];
#pragma unroll
        for (int r = 0; r < 16; ++r) rl[r] = __builtin_amdgcn_rcpf(wsf[32 + crow(r, hi)]);
        asm volatile("s_waitcnt lgkmcnt(0)\n\ts_barrier" ::: "memory");
        LAS float* X = (LAS float*)lds + wq * 4096;
        if (wsel == 1) {
#pragma unroll
            for (int d = 0; d < ND; ++d)
#pragma unroll
                for (int r = 0; r < 16; ++r) X[(d * 16 + r) * 64 + lane] = o[d][r] * rl[r];
        }
        __syncthreads();
        if (wsel == 0) {
            float ss[16];
#pragma unroll
            for (int r = 0; r < 16; ++r) { float s = 0.f;
#pragma unroll
                for (int d = 0; d < ND; ++d) { const float v = o[d][r] * rl[r] - u.lam * X[(d * 16 + r) * 64 + lane]; o[d][r] = v; s += v * v; }
                ss[r] = s; }
#pragma unroll
            for (int r = 0; r < 16; ++r) { float s = ss[r]; s += __shfl_xor(s, 1); s += __shfl_xor(s, 2); s += __shfl_xor(s, 4); s += __shfl_xor(s, 8); s += __shfl_xor(s, 16); ss[r] = rsqrtf(s * (1.f / 128.f) + EPS) * u.post; }
            bf16* Ow = u.O + (size_t)(wq * 32) * u.ldo;
#pragma unroll
            for (int d = 0; d < ND; ++d) { const float g = u.gsub[d * 32 + r32];
#pragma unroll
                for (int r = 0; r < 16; ++r) { const float v = o[d][r] * ss[r] * g; Ow[(size_t)crow(r, hi) * u.ldo + d * 32 + r32] = (bf16)(cvtpk_s(v, v) & 0xffffu); } }
        }
        __syncthreads();
    }
#undef HI_KROW
#undef HI_DMA_K
#undef HI_DMA_V
#undef HI_WAITB
#undef HI_MASK
#undef HI_ROWMAX
#undef HI_DECIDE
#undef HI_RESC
#undef HI_ROT
#undef HI_PE
#undef HI_VRD
#undef HI_VFR
#undef HI_STEP
#undef HI_ENDW
}
}

typedef GAS unsigned gu32;
#define RLX_AGENT __ATOMIC_RELAXED, __HIP_MEMORY_SCOPE_AGENT
#define LDS_WAIT() asm volatile("s_waitcnt lgkmcnt(0)" ::: "memory")
#define VM_WAIT() asm volatile("s_waitcnt vmcnt(0)" ::: "memory")
#define XB_TMO      128
#define XB_XCNT(j)  (256  + 64 * (j))
#define XB_XSUB(j)  (1280 + 64 * (j))
#define XB_XGEN(j)  (2304 + 64 * (j))
#define XB_TOP      3328
#define XB_TOPGEN   3392
#define XCD_BAR_WORDS 3456
#define XB_SPIN_CAP (1u << 18)
__device__ __forceinline__ unsigned xb_ld(unsigned* p)              { return __hip_atomic_load(p, __ATOMIC_RELAXED, __HIP_MEMORY_SCOPE_AGENT); }
__device__ __forceinline__ unsigned xb_add(unsigned* p, unsigned v) { return __hip_atomic_fetch_add(p, v, __ATOMIC_RELAXED, __HIP_MEMORY_SCOPE_AGENT); }
__device__ __forceinline__ unsigned xb_xcc_id() { return (unsigned)__builtin_amdgcn_s_getreg((3 << 11) | 20) & 0xFu; }
#define XB_SPIN(cond, bar) do { unsigned _sp = 0; while (cond) { __builtin_amdgcn_s_sleep(1); \
    if ((++_sp & 255u) == 0u) { if (xb_ld(&(bar)[XB_TMO])) break; if (_sp > XB_SPIN_CAP) { atomicAdd(&(bar)[XB_TMO], 1u); break; } } } } while (0)
struct XcdBarrier { unsigned* bar; unsigned x; volatile LAS unsigned* st; };
__device__ __forceinline__ XcdBarrier xcd_barrier_post(unsigned* bar, volatile LAS unsigned* st, const int wave) {
    XcdBarrier b; b.bar = bar; b.x = xb_xcc_id(); b.st = st;
    if (wave == 0 && lane_id() == 0) st[2] = xb_add(&bar[XB_XCNT(b.x)], 1u);
    return b;
}
__device__ __forceinline__ void xcd_barrier_complete(unsigned* bar, unsigned x, unsigned& nloc, unsigned& nx) {
    const unsigned G = gridDim.x * gridDim.y * gridDim.z;
    unsigned sum, cnt, mine, sp = 0u;
    for (;;) {
        sum = 0u; cnt = 0u; mine = 0u;
#pragma unroll
        for (unsigned j = 0; j < 16; ++j) { const unsigned c = xb_ld(&bar[XB_XCNT(j)]); sum += c; cnt += (c > 0u) ? 1u : 0u; mine = (j == x) ? c : mine; }
        if (sum == G) break;
        __builtin_amdgcn_s_sleep(1);
        if ((++sp & 255u) == 0u) { if (xb_ld(&bar[XB_TMO])) break; if (sp > XB_SPIN_CAP) { atomicAdd(&bar[XB_TMO], 1u); break; } }
    }
    nloc = mine > 0u ? mine : 1u; nx = cnt > 0u ? cnt : 1u;
}
__device__ __forceinline__ void xcd_barrier(const XcdBarrier& b, const int wave) {
    asm volatile("s_waitcnt vmcnt(0)" ::: "memory");
    __syncthreads();
    if (wave == 0 && lane_id() == 0) {
        unsigned* bar = b.bar;
        __builtin_amdgcn_s_waitcnt(0);
        unsigned nloc = b.st[0], nx = b.st[1];
        if (nloc == 0u) { xcd_barrier_complete(bar, b.x, nloc, nx); b.st[0] = nloc; b.st[1] = nx; }
        const unsigned old = xb_add(&bar[XB_XSUB(b.x)], 1u);
        const unsigned gen = old / nloc;
        if (old + 1u == (gen + 1u) * nloc) {
            __builtin_amdgcn_fence(__ATOMIC_RELEASE, "agent");
            asm volatile("s_waitcnt vmcnt(0)" ::: "memory");
            const unsigned og = xb_add(&bar[XB_TOP], 1u);
            const unsigned tg = og / nx;
            if (og + 1u == (tg + 1u) * nx) {
#pragma unroll
                for (unsigned j = 0; j < 16; ++j) __hip_atomic_fetch_add(&bar[XB_XGEN(j)], 1u, __ATOMIC_RELAXED, __HIP_MEMORY_SCOPE_AGENT);
            }
        }
        XB_SPIN(xb_ld(&bar[XB_XGEN(b.x)]) == gen, bar);
        __builtin_amdgcn_fence(__ATOMIC_ACQUIRE, "agent");
        asm volatile("s_waitcnt vmcnt(0)" ::: "memory");
    }
    __syncthreads();
}

__device__ __forceinline__ void vcu_setup(const XcdBarrier& b, const int wave) {
    if (wave == 0 && lane_id() == 0) { unsigned pre = 0u;
        for (unsigned j = 0; j < 16; ++j) { const unsigned c = xb_ld(&b.bar[XB_XCNT(j)]); if (j < b.x) pre += c; }
        b.st[3] = pre + b.st[2] + 1u; }
}
struct Frame {
    LAS unsigned char* lds; volatile LAS unsigned* MISC; gu32* ctl;
    int wave, G, blk;
    const LAS Tensors* Tl; float* out; unsigned char* ws;
};
__device__ __forceinline__ const float* uni_ptr(const float* const LAS* p) { const unsigned long long v = *(const LAS unsigned long long*)p; const unsigned lo = __builtin_amdgcn_readfirstlane((unsigned)v), hi = __builtin_amdgcn_readfirstlane((unsigned)(v >> 32)); return (const float*)(((unsigned long long)hi << 32) | lo); }
#define TT(name) uni_ptr(&F.Tl->name)
#define FLANE lane_id()
#define FTID (F.wave * 64 + lane_id())
__device__ __forceinline__ bf16* residual_row(const Frame& F, int tok) { return (bf16*)(F.ws + R_HB) + (size_t)tok * DM; }

__device__ __forceinline__ int rot32perm(int i) { const int blk = i >> 4, w = i & 15; return blk * 16 + 2 * (w & 7) + (w >> 3); }
__device__ __forceinline__ int rot64perm(int i) { const int blk = i >> 5, w = i & 31; return blk * 32 + 2 * (w & 15) + (w >> 4); }
__device__ __forceinline__ int drow_map(int kind, int n) {
    switch (kind) {
    case 1: if (n < 640) return n; if (n < 672) return 640 + rot32perm(n - 640); if (n < 1312) { const int base = n < 1184 ? 672 : 1184; const int c = n - base; return base + (c & ~63) + rot64perm(c & 63); } return n;
    case 2: { const int h = n / 96, w = n % 96; return w < 64 ? n : h * 96 + 64 + rot32perm(w - 64); }
    case 3: { const int h = n / 384, w = n % 384; return w < 256 ? h * 384 + (w & ~63) + rot64perm(w & 63) : n; }
    case 4: return 2 * n;
    case 5: return 2 * n + 1;
    default: return n;
    }
}
struct TJob { const float* src; bf16* dst; const float* kscale; int K, N, nbatch, kind; size_t dstb; };
struct TLoc { const float* W; bf16* WT; const float* kscale; int K, N, kind, k0, n0; };
__device__ __forceinline__ TLoc transpose_locate(const TJob& J, int item) {
    const int nblk = (J.N + 63) / 64; const int per = (J.K / 64) * nblk; const int bidx = item / per; const int r = item % per;
    const int kb = r / nblk, nb = r % nblk;
    return TLoc{J.src + (size_t)bidx * J.K * J.N, J.dst + (size_t)bidx * J.dstb, J.kscale, J.K, J.N, J.kind, 64 * kb, 64 * nb};
}
__device__ __forceinline__ void transpose_load(const TLoc& L, f32x4 (&v)[16], int lane) {
    const int m4 = 4 * (lane & 15), kq = lane >> 4;
    const bool nin = L.n0 + m4 < L.N;
#pragma unroll
    for (int i = 0; i < 16; ++i) { const int k = L.k0 + 4 * i + kq; v[i] = nin ? __builtin_nontemporal_load((const f32x4*)(L.W + (size_t)k * L.N + L.n0 + m4)) : (f32x4){0.f, 0.f, 0.f, 0.f}; }
}
__device__ __forceinline__ void transpose_finish(const TLoc& L, f32x4 (&v)[16], LAS float* scr, int lane) {
    const int m4 = 4 * (lane & 15), kq = lane >> 4;
    if (L.kscale) {
#pragma unroll
        for (int i = 0; i < 16; ++i) v[i] = v[i] * L.kscale[L.k0 + 4 * i + kq]; }
#pragma unroll
    for (int i = 0; i < 16; ++i) { const int kk = 4 * i + kq; *(LAS f32x4*)(scr + kk * 64 + (m4 ^ (4 * (kk >> 3)))) = v[i]; }
    LDS_WAIT(); asm volatile("" ::: "memory");
    const int c = lane & 7, nl = lane >> 3;
#pragma unroll
    for (int j = 0; j < 8; ++j) { const int n = 8 * j + nl; const LAS float* sp = scr + (8 * c) * 64 + (n ^ (4 * c));
        u32x4 o; o.x = cvt_pk_bf16(sp[0], sp[64]); o.y = cvt_pk_bf16(sp[128], sp[192]); o.z = cvt_pk_bf16(sp[256], sp[320]); o.w = cvt_pk_bf16(sp[384], sp[448]);
        if (L.n0 + n < L.N) *(u32x4*)(L.WT + (size_t)drow_map(L.kind, L.n0 + n) * L.K + L.k0 + 8 * c) = o; }
    LDS_WAIT(); asm volatile("" ::: "memory");
}
__device__ __forceinline__ int job_items(const TJob& J) { return (J.K / 64) * ((J.N + 63) / 64) * J.nbatch; }
template <int NJ> __device__ __forceinline__ void run_jobs(const Frame& F, const TJob (&jobs)[NJ], int widx = -1, int nw = 0) {
    LAS float* scr = (LAS float*)(F.lds + F.wave * 16384);
    const int gw = (widx < 0 ? F.blk : widx) * 8 + F.wave, NGW = (widx < 0 ? F.G : nw) * 8, lane = FLANE;
    int total = 0;
#pragma unroll
    for (int j = 0; j < NJ; ++j) total += job_items(jobs[j]);
#define TJ_LOCATE(L, it_) do { int r_ = (it_); L = transpose_locate(jobs[0], 0); \
      _Pragma("unroll") for (int j = 0; j < NJ; ++j) { const int n_ = job_items(jobs[j]); if (r_ >= 0 && r_ < n_) L = transpose_locate(jobs[j], r_); r_ -= n_; } } while (0)
    f32x4 vA[16], vB[16]; TLoc LA, LB;
    int it = gw;
    if (it < total) { TJ_LOCATE(LA, it); transpose_load(LA, vA, lane); }
    while (it < total) {
        int nit = it + NGW;
        if (nit < total) { TJ_LOCATE(LB, nit); transpose_load(LB, vB, lane); }
        transpose_finish(LA, vA, scr, lane);
        it = nit; if (it >= total) break;
        nit = it + NGW;
        if (nit < total) { TJ_LOCATE(LA, nit); transpose_load(LA, vA, lane); }
        transpose_finish(LB, vB, scr, lane);
        it = nit;
    }
#undef TJ_LOCATE
}
__device__ __forceinline__ void convert_expert_weights(const Frame& F, int l) {
    unsigned char* ws = F.ws; bf16* WGU = (bf16*)(ws + WS_WGU); bf16* WD = (bf16*)(ws + WS_WD);
    const size_t eoff = (size_t)l * NEXP * DM * FF, soff = (size_t)l * DM * FF;
    const TJob jobs[6] = {
        {TT(we_gate) + eoff, WGU, nullptr, DM, FF, NEXP, 4, (size_t)512 * DM},
        {TT(we_up) + eoff, WGU, nullptr, DM, FF, NEXP, 5, (size_t)512 * DM},
        {TT(we_down) + eoff, WD, nullptr, FF, DM, NEXP, 0, (size_t)DM * FF},
        {TT(ws_gate) + soff, WGU + (size_t)NEXP * 512 * DM, nullptr, DM, FF, 1, 4, (size_t)512 * DM},
        {TT(ws_up) + soff, WGU + (size_t)NEXP * 512 * DM, nullptr, DM, FF, 1, 5, (size_t)512 * DM},
        {TT(ws_down) + soff, WD + (size_t)NEXP * DM * FF, nullptr, FF, DM, 1, 0, (size_t)DM * FF}};
    run_jobs<6>(F, jobs);
}
__device__ __forceinline__ void p0_prologue(const Frame& F) {
    unsigned char* ws = F.ws;
    if (F.blk < 96) {
        LAS float* sil = (LAS float*)(F.lds + 40960);
        for (int i = FTID; i < 9 * DM; i += 512) { const int r = i / DM, k = i % DM; const float xv = r < 8 ? TT(c)[r * DM + k] : TT(c_ctx)[k]; sil[k * 12 + r] = xv / (1.f + __expf(-xv)); }
        __syncthreads();
    }
    for (int task = F.blk; task < 96; task += F.G) {
        const int lane = FLANE; const int l = task / 48, c0 = (task % 48) * 128 + 2 * lane;
        const LAS float* sil = (const LAS float*)(F.lds + 40960);
        float a0[9], a1[9];
#pragma unroll
        for (int r = 0; r < 9; ++r) { a0[r] = 0.f; a1[r] = 0.f; }
        const float* wp = TT(w_ada) + ((size_t)l * DM + F.wave * 128) * 6144 + c0;
#pragma unroll 1
        for (int k0 = 0; k0 < 128; k0 += 16) {
            f32x2 wv_[16];
#pragma unroll
            for (int q = 0; q < 16; ++q) wv_[q] = *(const f32x2*)(wp + (size_t)(k0 + q) * 6144);
#pragma unroll
        for (int q = 0; q < 16; ++q) { const int kk = k0 + q;
            const int k = F.wave * 128 + kk; const f32x2 w2 = wv_[q];
            const f32x4 s0 = *(const LAS f32x4*)(sil + k * 12), s1 = *(const LAS f32x4*)(sil + k * 12 + 4), s2 = *(const LAS f32x4*)(sil + k * 12 + 8);
            const float sv[9] = {s0[0], s0[1], s0[2], s0[3], s1[0], s1[1], s1[2], s1[3], s2[0]};
#pragma unroll
            for (int r = 0; r < 9; ++r) { a0[r] = fmaf(sv[r], w2[0], a0[r]); a1[r] = fmaf(sv[r], w2[1], a1[r]); }
        } }
        LAS float* part = (LAS float*)F.lds;
#pragma unroll
        for (int r = 0; r < 9; ++r) { part[(F.wave * 9 + r) * 128 + 2 * lane] = a0[r]; part[(F.wave * 9 + r) * 128 + 2 * lane + 1] = a1[r]; }
        __syncthreads();
        float* mod = (float*)(ws + WS_MOD) + (size_t)l * 9 * 6144;
        for (int i = FTID; i < 9 * 128; i += 512) { const int r = i / 128, cc = i % 128; float s = 0.f;
#pragma unroll
            for (int w = 0; w < 8; ++w) s += part[(w * 9 + r) * 128 + cc];
            const int col = (task % 48) * 128 + cc; mod[r * 6144 + col] = s + TT(b_ada)[l * 6144 + col]; }
        __syncthreads();
    }
    { f32x2* R64 = (f32x2*)(ws + WS_ROPE64); f32x2* R32 = (f32x2*)(ws + WS_ROPE32);
      const bool sub = F.G >= 192; const int wb_ = sub ? F.blk - 96 : F.blk, nwb_ = sub ? F.G - 96 : F.G;
      if (wb_ >= 0)
      for (int i = wb_ * 512 + FTID; i < SEQ * 48; i += nwb_ * 512) {
          const int t = i / 48, p = i % 48; const float prow = (float)(t >> 6), pcol = (float)(t & 63);
          if (p < 32) { const int blk = p >> 4, j = p & 15; const float inv = exp2f(-(float)(2 * j) / 32.f * 13.287712379549449f); const float ang = (blk ? pcol : prow) * inv; R64[t * 32 + p] = (f32x2){cosf(ang), sinf(ang)}; }
          else { const int q = p - 32, blk = q >> 3, j = q & 7; const float inv = exp2f(-(float)(2 * j) / 16.f * 13.287712379549449f); const float ang = (blk ? pcol : prow) * inv; R32[t * 16 + q] = (f32x2){cosf(ang), sinf(ang)}; }
      } }
    { const TJob jobs[6] = {
        {TT(wa_in), (bf16*)(ws + WS_WIN0), nullptr, DM, 1440, 1, 1, 0},
        {TT(wa_uq), (bf16*)(ws + WS_WUQ), TT(ga_q), 384, 768, 1, 2, 0},
        {TT(wa_ukv), (bf16*)(ws + WS_WUKV), TT(ga_kv), 256, 1024, 1, 0, 0},
        {TT(wa_out), (bf16*)(ws + WS_WOUT0), nullptr, DM, DM, 1, 0, 0},
        {TT(wc_in), (bf16*)(ws + WS_WIN1), nullptr, DM, 3072, 1, 3, 0},
        {TT(wc_out), (bf16*)(ws + WS_WOUT1), nullptr, DM, DM, 1, 0, 0}};
      if (F.G >= 192) { if (F.blk >= 96) run_jobs<6>(F, jobs, F.blk - 96, F.G - 96); } else run_jobs<6>(F, jobs); }
}
__device__ __forceinline__ void normmod_row(const float* hrow, const float* g, const float* sh, const float* sc, bf16* orow, int lane) {
    f32x4 v[4]; float s = 0.f;
#pragma unroll
    for (int j = 0; j < 4; ++j) { v[j] = *(const f32x4*)(hrow + 4 * (lane + 64 * j)); s += (v[j][0] * v[j][0] + v[j][1] * v[j][1]) + (v[j][2] * v[j][2] + v[j][3] * v[j][3]); }
    const float rstd = rsqrtf(wave_sum(s) * (1.f / DM) + EPS);
#pragma unroll
    for (int j = 0; j < 4; ++j) { const int c = 4 * (lane + 64 * j); const f32x4 gv = *(const f32x4*)(g + c), shv = *(const f32x4*)(sh + c), scv = *(const f32x4*)(sc + c);
        const f32x4 y = (v[j] * rstd * gv) * (scv + 1.f) + shv;
        u32x2 w; w.x = cvt_pk_bf16(y[0], y[1]); w.y = cvt_pk_bf16(y[2], y[3]); *(u32x2*)(orow + c) = w; }
}

__device__ __forceinline__ void route_row(float logit, float bias, int lane, int& rk_out, float& w_out) {
    const float s = 1.f / (1.f + __expf(-logit));
    const float bsd = s + bias;
    int rg = 0; const int gl = lane & 7;
#pragma unroll
    for (int k = 0; k < 8; ++k) { const float v = __shfl(bsd, (lane & ~7) | k); rg += ((v > bsd) || (v == bsd && k < gl)) ? 1 : 0; }
    float gs = rg < 2 ? bsd : 0.f;
    gs += __shfl_xor(gs, 1); gs += __shfl_xor(gs, 2); gs += __shfl_xor(gs, 4);
    int rkg = 0; const int g = lane >> 3;
#pragma unroll
    for (int gg = 0; gg < 8; ++gg) { const float v = __shfl(gs, gg * 8); rkg += ((v > gs) || (v == gs && gg < g)) ? 1 : 0; }
    const float msk = rkg < 4 ? bsd : -1e30f;
    int rk = 0; unsigned long long cand = __ballot(rkg < 4);
    while (cand) { const int j = __builtin_ctzll(cand); cand &= cand - 1ull;
        const float v = __builtin_bit_cast(float, __builtin_amdgcn_readlane(__builtin_bit_cast(int, msk), j)); rk += ((v > msk) || (v == msk && j < lane)) ? 1 : 0; }
    const bool sel = rk < 8 && rkg < 4;
    const float ssum = wave_sum(sel ? s : 0.f);
    rk_out = sel ? rk : -1; w_out = s / ssum * 2.5f;
}
__device__ __forceinline__ void route_phase(const Frame& F, int l, int ntok, const bool dry = false) {
    unsigned char* ws = F.ws;
    LAS float* wbuf = (LAS float*)F.lds;
    LAS int* hist = (LAS int*)(F.lds + 104448); LAS int* base = hist + 64;
    const int lane = FLANE, tid = F.wave * 64 + lane;
    LAS float* fch = (LAS float*)(F.lds + 65536) + F.wave * 1152;
    LAS int* st_i = (LAS int*)(F.lds + 104960) + F.wave * 144; LAS float* st_w = (LAS float*)(st_i + 72);
    if (tid < 64) hist[tid] = 0;
    for (int i = lane; i < 72; i += 64) st_i[i] = -1;
    const int gw = F.blk * 8 + F.wave, NGW = F.G * 8;
    const float* mod = (const float*)(ws + WS_MOD) + (size_t)l * 9 * 6144;
    const float* gf = TT(g_ffn) + l * DM; const float* wr = TT(w_router) + (size_t)l * DM * NEXP; const float bias = TT(b_router)[l * NEXP + lane];
    bf16* XN = (bf16*)(ws + R_F);
    u32x2 v[9][4]; float rstd[9];
#pragma unroll
    for (int r = 0; r < 9; ++r) {
        const int tok = gw + r * NGW; float s = 0.f;
        if (tok < ntok) { const bf16* hrow = residual_row(F, tok);
#pragma unroll
            for (int jj = 0; jj < 4; ++jj) { const u32x2 w_ = *(const u32x2*)(hrow + 4 * (lane + 64 * jj)); v[r][jj] = w_; const float e0 = bflo(w_.x), e1 = bfhi(w_.x), e2 = bflo(w_.y), e3 = bfhi(w_.y); s += (e0 * e0 + e1 * e1) + (e2 * e2 + e3 * e3); } }
        else {
#pragma unroll
            for (int jj = 0; jj < 4; ++jj) v[r][jj] = (u32x2){0u, 0u}; }
        rstd[r] = rsqrtf(wave_sum(s) * (1.f / DM) + EPS);
    }
    f32x2 acc2[9];
#pragma unroll
    for (int r = 0; r < 9; ++r) acc2[r] = (f32x2){0.f, 0.f};
    f32x4 wreg[4];
#pragma unroll
    for (int i = 0; i < 4; ++i) wreg[i] = *(const f32x4*)(wr + 4 * (tid + 512 * i));
#pragma unroll
    for (int ch = 0; ch < 8; ++ch) {
        LAS float* wb = wbuf + (ch & 1) * 8192;
#pragma unroll
        for (int i = 0; i < 4; ++i) *(LAS f32x4*)(wb + 4 * (tid + 512 * i)) = wreg[i];
        if (ch + 1 < 8) {
#pragma unroll
            for (int i = 0; i < 4; ++i) wreg[i] = *(const f32x4*)(wr + (ch + 1) * 8192 + 4 * (tid + 512 * i)); }
        if ((lane >> 5) == (ch & 1) && !(dry && (RDS & 2))) {
            const int cl = 4 * (lane & 31), c = 128 * ch + cl; const f32x4 gv = *(const f32x4*)(gf + c);
#pragma unroll
            for (int r = 0; r < 9; ++r) {
                const int tok = gw + r * NGW;
                if (tok < ntok) { const int mr = tok < NLAT ? (tok >> 11) : 8;
                    const f32x4 shv = *(const f32x4*)(mod + mr * 6144 + 3072 + c), scv = *(const f32x4*)(mod + mr * 6144 + 4096 + c);
                    const u32x2 vw = v[r][ch >> 1]; const f32x4 vx = (f32x4){bflo(vw.x), bfhi(vw.x), bflo(vw.y), bfhi(vw.y)};
                    const f32x4 y = (vx * rstd[r] * gv) * (scv + 1.f) + shv;
                    u32x2 w; w.x = cvt_pk_bf16(y[0], y[1]); w.y = cvt_pk_bf16(y[2], y[3]); *(u32x2*)(XN + (size_t)tok * DM + c) = w;
                    *(LAS f32x4*)(fch + r * 128 + cl) = y; }
            }
        }
        __syncthreads();
        if (!(dry && (RDS & 1)))
#pragma unroll 1
        for (int c4 = 0; c4 < 32; ++c4) {
            const f32x2 w01 = (f32x2){wb[(4 * c4 + 0) * 64 + lane], wb[(4 * c4 + 1) * 64 + lane]}, w23 = (f32x2){wb[(4 * c4 + 2) * 64 + lane], wb[(4 * c4 + 3) * 64 + lane]};
            f32x4 fa[5], fb[4];
#pragma unroll
            for (int r = 0; r < 5; ++r) fa[r] = *(const LAS f32x4*)(fch + r * 128 + 4 * c4);
#pragma unroll
            for (int r = 0; r < 4; ++r) fb[r] = *(const LAS f32x4*)(fch + (5 + r) * 128 + 4 * c4);
#pragma unroll
            for (int r = 0; r < 5; ++r) { acc2[r] = (f32x2){fa[r][0], fa[r][1]} * w01 + acc2[r]; acc2[r] = (f32x2){fa[r][2], fa[r][3]} * w23 + acc2[r]; }
#pragma unroll
            for (int r = 0; r < 4; ++r) { acc2[5 + r] = (f32x2){fb[r][0], fb[r][1]} * w01 + acc2[5 + r]; acc2[5 + r] = (f32x2){fb[r][2], fb[r][3]} * w23 + acc2[5 + r]; }
        }
    }
    float acc[9];
#pragma unroll
    for (int r = 0; r < 9; ++r) acc[r] = acc2[r][0] + acc2[r][1];
#pragma unroll
    for (int r = 0; r < 9; ++r) {
        const int tok = gw + r * NGW;
        if (tok < ntok && !(dry && (RDS & 4))) {
            int rk; float w; route_row(acc[r], bias, lane, rk, w);
            if (rk >= 0 && !dry) { const int pos = atomicAdd((int*)(hist + lane), 1); st_i[r * 8 + rk] = (pos << 8) | lane; st_w[r * 8 + rk] = w; }
        }
    }
    __syncthreads();
    int* cntg = (int*)(F.ctl) + CW_CNT + l * 64;
    if (tid < 64 && !dry) base[tid] = atomicAdd(cntg + tid, hist[tid]);
    __syncthreads();
    int* list = (int*)(ws + WS_LIST); float* w8 = (float*)(ws + WS_W8);
    for (int i = lane; i < 72; i += 64) {
        const int pk = st_i[i];
        if (pk >= 0) { const int e = pk & 255, tok = gw + (i >> 3) * NGW; const int dest = tok * 8 + (i & 7); list[(size_t)e * NT + base[e] + (pk >> 8)] = dest; ((float*)(ws + WS_LW))[dest] = st_w[i]; ((int*)w8)[dest] = (e << 16) | (base[e] + (pk >> 8)); }
    }
    __syncthreads();
}
__device__ __forceinline__ void moe_setup(const Frame& F, int l, int ntok) {
    LAS int* pfx = (LAS int*)(F.lds + LDS_PFX); LAS int* cnt = (LAS int*)(F.lds + LDS_CNT);
    __syncthreads();
    if (F.wave == 0) {
        const int lane = FLANE; const int* cntg = (const int*)(F.ctl) + CW_CNT + l * 64;
        const int n = __hip_atomic_load(cntg + lane, __ATOMIC_RELAXED, __HIP_MEMORY_SCOPE_AGENT);
        cnt[lane] = n; LDS_WAIT(); asm volatile("" ::: "memory");
        int excl = 0;
#pragma unroll 8
        for (int j = 0; j < 64; ++j) { const int tj = (cnt[j] + 255) >> 8; excl += j < lane ? tj : 0; }
        pfx[lane] = excl; const int incl = excl + ((n + 255) >> 8);
        if (lane == 63) { cnt[64] = ntok; pfx[64] = incl; pfx[65] = incl + (ntok >> 8); }
    }
    __syncthreads();
}
__device__ __forceinline__ void combine_phase(const Frame& F, int l, int ntok, const bool dry = false) {
    unsigned char* ws = F.ws;
    const int gw = F.blk * 8 + F.wave, NGW = F.G * 8, lane = FLANE, c0 = 16 * lane;
    const unsigned char* Yc = ws + R_YC; const float* YS = (const float*)(ws + WS_YS);
    const int* inv = (const int*)(ws + WS_W8); const LAS int* pfx = (const LAS int*)(F.lds + LDS_PFX);
    const float* wtok = (const float*)(ws + WS_LW);
    const float* mod = (const float*)(ws + WS_MOD) + (size_t)l * 9 * 6144;
    for (int tok = gw; tok < ntok; tok += NGW) {
        float y[16];
#pragma unroll
        for (int i = 0; i < 16; ++i) y[i] = 0.f;
        float sb = 0.f;
#pragma unroll
        for (int j = 0; j < 9; ++j) { const int code = j < 8 ? inv[(size_t)tok * 8 + j] : ((64 << 16) | tok);
            const size_t yr = (size_t)pfx[code >> 16] * 256 + (code & 0xffff); const float gw8 = j < 8 ? wtok[(size_t)tok * 8 + j] : 1.f;
            const u32x4 a = *(const u32x4*)(Yc + yr * DM + c0); const float s = YS[yr * 4 + (lane >> 4)] * gw8; sb += s;
            const unsigned aw[4] = {a.x, a.y, a.z, a.w};
#pragma unroll
            for (int k = 0; k < 4; ++k) { y[4 * k] = fmaf((float)((aw[k] >> 0) & 0xffu), s, y[4 * k]); y[4 * k + 1] = fmaf((float)((aw[k] >> 8) & 0xffu), s, y[4 * k + 1]);
                y[4 * k + 2] = fmaf((float)((aw[k] >> 16) & 0xffu), s, y[4 * k + 2]); y[4 * k + 3] = fmaf((float)((aw[k] >> 24) & 0xffu), s, y[4 * k + 3]); }
        }
#pragma unroll
        for (int i = 0; i < 16; ++i) y[i] -= 128.f * sb;
        bf16* hrow = residual_row(F, tok); const int mr = tok < NLAT ? (tok >> 11) : 8;
        float hv16[16];
        { const u32x4 a_ = *(const u32x4*)(hrow + c0), b_ = *(const u32x4*)(hrow + c0 + 8); const unsigned ww_[8] = {a_.x, a_.y, a_.z, a_.w, b_.x, b_.y, b_.z, b_.w};
#pragma unroll
          for (int i = 0; i < 8; ++i) { hv16[2 * i] = bflo(ww_[i]); hv16[2 * i + 1] = bfhi(ww_[i]); } }
        const float* gt = mod + mr * 6144 + 5120 + c0;
        f32x4 h[4]; float s = 0.f;
#pragma unroll
        for (int j = 0; j < 4; ++j) { const f32x4 hv = (f32x4){hv16[4 * j], hv16[4 * j + 1], hv16[4 * j + 2], hv16[4 * j + 3]}, g4 = *(const f32x4*)(gt + 4 * j);
            h[j] = hv + g4 * (f32x4){y[4 * j], y[4 * j + 1], y[4 * j + 2], y[4 * j + 3]};
            s += (h[j][0] * h[j][0] + h[j][1] * h[j][1]) + (h[j][2] * h[j][2] + h[j][3] * h[j][3]); }
        const float rstd = rsqrtf(wave_sum(s) * (1.f / DM) + EPS);
        if (dry) { asm volatile("" :: "v"(rstd), "v"(h[0]), "v"(h[1]), "v"(h[2]), "v"(h[3])); continue; }
        if (l == 0) {
            const float* mod1 = (const float*)(ws + WS_MOD) + (size_t)9 * 6144 + mr * 6144;
            const float* g = TT(g_mix) + DM + c0; bf16* arow = (bf16*)(ws + R_A1) + (size_t)tok * DM + c0;
            float o[16];
#pragma unroll
            for (int j = 0; j < 4; ++j) {
                const f32x4 gv = *(const f32x4*)(g + 4 * j), shv = *(const f32x4*)(mod1 + c0 + 4 * j), scv = *(const f32x4*)(mod1 + 1024 + c0 + 4 * j);
                const f32x4 yv = (h[j] * rstd * gv) * (scv + 1.f) + shv; o[4 * j] = yv[0]; o[4 * j + 1] = yv[1]; o[4 * j + 2] = yv[2]; o[4 * j + 3] = yv[3]; }
            const float o0[8] = {o[0], o[1], o[2], o[3], o[4], o[5], o[6], o[7]}, o1[8] = {o[8], o[9], o[10], o[11], o[12], o[13], o[14], o[15]};
            store8(arow, o0); store8(arow + 8, o1);
            { const float h0[8] = {h[0][0], h[0][1], h[0][2], h[0][3], h[1][0], h[1][1], h[1][2], h[1][3]}, h1[8] = {h[2][0], h[2][1], h[2][2], h[2][3], h[3][0], h[3][1], h[3][2], h[3][3]};
              store8(hrow + c0, h0); store8(hrow + c0 + 8, h1); }
        } else {
            const float* g = TT(g_final) + c0;
#pragma unroll
            for (int j = 0; j < 4; ++j) { const f32x4 gv = *(const f32x4*)(g + 4 * j); *(f32x4*)(F.out + (size_t)tok * DM + c0 + 4 * j) = h[j] * rstd * gv; }
        }
    }
}
__device__ __forceinline__ void diff_combine_phase(const Frame& F) {
    unsigned char* ws = F.ws;
    const int gw = F.blk * 8 + F.wave, NGW = F.G * 8, lane = FLANE, c0 = 16 * lane;
    const float lam_init = 0.8f - 0.6f * 0.7408182206817179f;
    const float d1 = wave_sum(TT(lam_q1)[lane] * TT(lam_k1)[lane]), d2 = wave_sum(TT(lam_q2)[lane] * TT(lam_k2)[lane]);
    const float lam = expf(d1) - expf(d2) + lam_init;
    const bf16* OA = (const bf16*)(ws + R_OA); const bf16* OB = (const bf16*)(ws + R_OB); bf16* O1 = (bf16*)(ws + R_O1);
    float gs[16];
#pragma unroll
    for (int i = 0; i < 16; ++i) gs[i] = TT(gc_sub)[(c0 & 127) + i] * (1.f - lam_init);
    for (int row = gw; row < NLAT; row += NGW) {
        const u32x4 a0 = *(const u32x4*)(OA + (size_t)row * DM + c0), a1 = *(const u32x4*)(OA + (size_t)row * DM + c0 + 8);
        const u32x4 b0 = *(const u32x4*)(OB + (size_t)row * DM + c0), b1 = *(const u32x4*)(OB + (size_t)row * DM + c0 + 8);
        const unsigned aw[8] = {a0.x, a0.y, a0.z, a0.w, a1.x, a1.y, a1.z, a1.w}, bw[8] = {b0.x, b0.y, b0.z, b0.w, b1.x, b1.y, b1.z, b1.w};
        float o[16]; float s = 0.f;
#pragma unroll
        for (int i = 0; i < 8; ++i) { o[2 * i] = bflo(aw[i]) - lam * bflo(bw[i]); o[2 * i + 1] = bfhi(aw[i]) - lam * bfhi(bw[i]); s += o[2 * i] * o[2 * i] + o[2 * i + 1] * o[2 * i + 1]; }
        s += __shfl_xor(s, 1); s += __shfl_xor(s, 2); s += __shfl_xor(s, 4);
        const float rstd = rsqrtf(s * (1.f / 128.f) + EPS);
        float v0[8], v1[8];
#pragma unroll
        for (int i = 0; i < 8; ++i) { v0[i] = o[i] * rstd * gs[i]; v1[i] = o[8 + i] * rstd * gs[8 + i]; }
        store8(O1 + (size_t)row * DM + c0, v0); store8(O1 + (size_t)row * DM + c0 + 8, v1);
    }
}

#ifndef MOE_FUSED
#define MOE_FUSED 0
#endif
__device__ __forceinline__ int vcu_of(const Frame& F) { const unsigned v = F.MISC[11]; return v ? (int)v - 1 : F.blk; }
__device__ __forceinline__ void moe_gemm1_phase(const Frame& F, int l, int ntok) {
    unsigned char* ws = F.ws; moe_setup(F, l, ntok);
    SchedMoe S0{(const LAS int*)(F.lds + LDS_PFX), (const LAS int*)(F.lds + LDS_CNT), (const int*)(ws + WS_LIST), 2, F.G, vcu_of(F), -1, nullptr};
    S0.build((LAS int*)(F.lds + LDS_UTAB), F.wave); SchedMoe S = S0; S.tab = (const LAS int*)(F.lds + LDS_UTAB);
    pg8::Gemm g{(const bf16*)(ws + R_F), (const bf16*)(ws + WS_WGU), DM}; EpiGemm1 E{(bf16*)(ws + R_H)};
    pg8::gemm_phase<EpiGemm1, SchedMoe, true, true, true>(F.lds, g, S, E, F.wave);
}
__device__ __forceinline__ void moe_gemm2_phase(const Frame& F, int l, int ntok, const float* modl, const bool dry) {
    unsigned char* ws = F.ws; moe_setup(F, l, ntok);
    SchedMoe S0{(const LAS int*)(F.lds + LDS_PFX), (const LAS int*)(F.lds + LDS_CNT), (const int*)(ws + WS_LIST), 4, F.G, vcu_of(F), -1, nullptr};
    S0.build((LAS int*)(F.lds + LDS_UTAB), F.wave); SchedMoe S = S0; S.tab = (const LAS int*)(F.lds + LDS_UTAB);
    pg8::Gemm g{(const bf16*)(ws + R_H), (const bf16*)(ws + WS_WD), FF};
    EpiGemm2 E{ws + R_YC, (const int*)(ws + WS_LIST), (const float*)(ws + WS_LW), (const LAS int*)(F.lds + LDS_CNT), F.out, (float*)(ws + WS_HCTX), modl, dry, (bf16*)(ws + R_H), (float*)(ws + WS_YS), (LAS float*)(F.lds + LDS_RSTD)};
    pg8::gemm_phase<EpiGemm2, SchedMoe, true, false, true>(F.lds, g, S, E, F.wave);
}
__device__ __forceinline__ void moe_fused_phase(const Frame& F, int l, int ntok, const float* modl, const bool dry) {
    unsigned char* ws = F.ws; LAS unsigned char* ring = F.lds;
    moe_setup(F, l, ntok);
    const LAS int* pfx = (const LAS int*)(F.lds + LDS_PFX); const LAS int* cnt = (const LAS int*)(F.lds + LDS_CNT);
    const int total = pfx[65];
    const bool xcd = false && (F.G & 7) == 0; const int x = F.blk & 7, j = F.blk >> 3, Gx = F.G >> 3, Tc = (total + 7) >> 3;
    for (int it = 0;; ++it) {
        int T;
        if (xcd) { const int Tl = it * Gx + j; T = x * Tc + Tl; if (Tl >= Tc || T >= total) break; }
        else { const unsigned v = F.MISC[11]; const int vcu = v ? (int)v - 1 : F.blk; T = it * F.G + vcu; if (T >= total) break; }
        { SchedMoe S{pfx, cnt, (const int*)(ws + WS_LIST), 2, F.G, F.blk, T, nullptr};
          pg8::Gemm g{(const bf16*)(ws + R_F), (const bf16*)(ws + WS_WGU), DM}; EpiGemm1 E{(bf16*)(ws + R_H)};
          pg8::gemm_phase<EpiGemm1, SchedMoe, true, true, true>(ring, g, S, E, F.wave); }
        if (F.wave == 0 && lane_id() == 0) __builtin_amdgcn_fence(__ATOMIC_ACQUIRE, "agent");
        asm volatile("s_waitcnt vmcnt(0)" ::: "memory"); __syncthreads();
        if (!(dry && (RDS & 8)))
        { SchedMoe S{pfx, cnt, (const int*)(ws + WS_LIST), 4, F.G, F.blk, T, nullptr};
          pg8::Gemm g{(const bf16*)(ws + R_H), (const bf16*)(ws + WS_WD), FF};
          EpiGemm2 E{ws + R_YC, (const int*)(ws + WS_LIST), (const float*)(ws + WS_LW), cnt, F.out, (float*)(ws + WS_HCTX), modl, dry, (bf16*)(ws + R_H), (float*)(ws + WS_YS), (LAS float*)(F.lds + LDS_RSTD)};
          pg8::gemm_phase<EpiGemm2, SchedMoe, true, false>(ring, g, S, E, F.wave); }
    }
}

struct Args { Tensors T; int ph_lo, ph_hi, li, pad; };

__global__ void __launch_bounds__(512, 2) mk_fwd(Args args) {
    extern __shared__ __attribute__((aligned(16))) unsigned char lds_raw[];
    asm volatile(".rept " PADSTR "\n\ts_nop 0\n\t.endr");
    Frame F;
    F.lds = (LAS unsigned char*)lds_raw;
    F.MISC = (volatile LAS unsigned*)(F.lds + MISC_OFF);
    F.wave = __builtin_amdgcn_readfirstlane((int)threadIdx.x >> 6);
    F.G = gridDim.x; F.blk = blockIdx.x;
    F.out = args.T.out; F.ws = args.T.ws;
    unsigned char* ws = args.T.ws;
    F.ctl = (gu32*)(ws + WS_CTL);
    for (int u = FTID; u < (LDS_BYTES - LDSCTL_OFF) / 4; u += 512) ((LAS unsigned*)(F.lds + LDSCTL_OFF))[u] = 0u;
    __syncthreads();
    { LAS Tensors* tl = (LAS Tensors*)(F.lds + LDS_TENS); F.Tl = tl; if (FTID < (int)(sizeof(Tensors) / 8)) ((LAS unsigned long long*)tl)[FTID] = ((const unsigned long long*)&args.T)[FTID]; }
    __syncthreads();
    XcdBarrier bar; bar.bar = (unsigned*)(F.ctl + CW_BAR); bar.x = 0; bar.st = nullptr;
    if (MK_SINGLE) bar = xcd_barrier_post((unsigned*)(F.ctl + CW_BAR), F.MISC + 8, F.wave);
    const int lo = args.ph_lo, hi = args.ph_hi;
#ifndef PHMASK
#define PHMASK 0xFFFFFFFFu
#endif
#define IN(k) (((PHMASK >> (k)) & 1u) && lo <= (k) && (k) < hi)
#ifndef PHREP
#define PHREP 0u
#endif
#define PHASE(k, ...) do { if (IN(k)) { const bool dry_ = false; (void)dry_; __VA_ARGS__ } if (((PHREP >> (k)) & 1u) && IN(k)) { xcd_barrier(bar, F.wave); const bool dry_ = true; (void)dry_; __VA_ARGS__ } } while (0);
#define SEAM(k) do { if (IN(k) && IN((k) + 1)) xcd_barrier(bar, F.wave); } while (0)
    LAS unsigned char* ring = F.lds;
    const f32x2* R64 = (const f32x2*)(ws + WS_ROPE64); const f32x2* R32 = (const f32x2*)(ws + WS_ROPE32);
    const float* MOD0 = (const float*)(ws + WS_MOD); const float* MOD1 = MOD0 + 9 * 6144;
    float* HCTX = (float*)(ws + WS_HCTX);

    PHASE(0,  p0_prologue(F); ) SEAM(0);
    if (MK_SINGLE) { vcu_setup(bar, F.wave); __syncthreads(); }
    const int vcu = __builtin_amdgcn_readfirstlane(vcu_of(F)); const int cx = (F.G & 7) == 0 ? (vcu % (F.G >> 3)) * 8 + vcu / (F.G >> 3) : vcu;
    PHASE(1,
        const int gw = F.blk * 8 + F.wave, NGW = F.G * 8; bf16* XN = (bf16*)(ws + R_XN);
        for (int tok0 = gw; tok0 < NT; tok0 += 3 * NGW) {
            const int lane = FLANE; f32x4 v[3][4];
_Pragma("unroll")
            for (int r = 0; r < 3; ++r) { const int tok = tok0 + r * NGW;
                if (tok < NT) { const float* hrow = tok < NLAT ? TT(x) + (size_t)tok * DM : TT(ctx) + (size_t)(tok - NLAT) * DM;
_Pragma("unroll")
                    for (int j = 0; j < 4; ++j) v[r][j] = *(const f32x4*)(hrow + 4 * (lane + 64 * j)); }
                else {
_Pragma("unroll")
                    for (int j = 0; j < 4; ++j) v[r][j] = (f32x4){0.f, 0.f, 0.f, 0.f}; } }
_Pragma("unroll")
            for (int r = 0; r < 3; ++r) { const int tok = tok0 + r * NGW; if (tok >= NT) break;
                const int mr = tok < NLAT ? (tok >> 11) : 8; const float* sh = MOD0 + mr * 6144; const float* sc = sh + 1024; const float* g = TT(g_mix); bf16* orow = XN + (size_t)tok * DM;
                float s = 0.f;
_Pragma("unroll")
                for (int j = 0; j < 4; ++j) s += (v[r][j][0] * v[r][j][0] + v[r][j][1] * v[r][j][1]) + (v[r][j][2] * v[r][j][2] + v[r][j][3] * v[r][j][3]);
                const float rstd = rsqrtf(wave_sum(s) * (1.f / DM) + EPS);
_Pragma("unroll")
                for (int j = 0; j < 4; ++j) { const int c = 4 * (lane + 64 * j); const f32x4 gv = *(const f32x4*)(g + c), shv = *(const f32x4*)(sh + c), scv = *(const f32x4*)(sc + c);
                    const f32x4 y = (v[r][j] * rstd * gv) * (scv + 1.f) + shv;
                    u32x2 w; w.x = cvt_pk_bf16(y[0], y[1]); w.y = cvt_pk_bf16(y[2], y[3]); *(u32x2*)(orow + c) = w; } }
        }
    ) SEAM(1);
    PHASE(2,
        pg8::Gemm g{(const bf16*)(ws + R_XN), (const bf16*)(ws + WS_WIN0), DM}; pg8::StaticOrder S; S.init(NT, 1536, F.G, cx);
        EpiInProj0 E{(bf16*)(ws + R_CQ), (bf16*)(ws + R_CKV), (bf16*)(ws + R_KR), (bf16*)(ws + R_QS), (bf16*)(ws + R_KS), (bf16*)(ws + R_VS), R64, R32, (float*)(ws + R_SSQ)};
        pg8::gemm_phase<EpiInProj0, pg8::StaticOrder, true, false>(ring, g, S, E, F.wave);
    ) SEAM(2);
    PHASE(3,
        const int GA = (F.G * 27) / 64 > 0 ? (F.G * 27) / 64 : 1; const bool isq = F.blk < GA || F.G < 2;
        LAS float* rst = (LAS float*)(F.lds + LDS_RSTD);
        pg8::StaticOrder S;
        if (isq) S.init(NT, 768, F.G < 2 ? 1 : GA, F.blk); else S.init(NT, 1024, F.G - GA, F.blk - GA);
        const bf16* A = isq ? (const bf16*)(ws + R_CQ) : (const bf16*)(ws + R_CKV); const int K = isq ? 384 : 256;
        { pg8::Unit u; const int tid = FTID; const float* SSQ = (const float*)(ws + R_SSQ);
          for (int i = 0; i < 4; ++i) { if (!S.next(i, u)) break;
              if (tid < 256) { const float* sp = SSQ + (size_t)(u.pm * 256 + tid) * 20 + (isq ? 0 : 12); float s = 0.f;
                  const f32x4 a = *(const f32x4*)sp, b = *(const f32x4*)(sp + 4); s = ((a[0] + a[1]) + (a[2] + a[3])) + ((b[0] + b[1]) + (b[2] + b[3]));
                  if (isq) { const f32x4 c = *(const f32x4*)(sp + 8); s += (c[0] + c[1]) + (c[2] + c[3]); }
                  rst[i * 256 + tid] = rsqrtf(s / (float)K + EPS); } }
          __syncthreads(); }
        { pg8::Gemm g{A, isq ? (const bf16*)(ws + WS_WUQ) : (const bf16*)(ws + WS_WUKV), K}; EpiUp E{isq ? (bf16*)(ws + R_Q) : (bf16*)(ws + R_KV), rst, R32, isq ? 768 : 1024, isq};
          pg8::gemm_phase<EpiUp, pg8::StaticOrder, true, false>(ring, g, S, E, F.wave); }
        if (F.G < 2) {   }
    ) SEAM(3);
    PHASE(4,
        const bf16* Q = (const bf16*)(ws + R_Q); const bf16* KV = (const bf16*)(ws + R_KV); const bf16* KR = (const bf16*)(ws + R_KR);
        const bf16* QS = (const bf16*)(ws + R_QS); const bf16* KS = (const bf16*)(ws + R_KS); const bf16* VS = (const bf16*)(ws + R_VS); bf16* O = (bf16*)(ws + R_O);
        for (int rep_ = 0; rep_ < P4REP_MLA; ++rep_)
        for (int U = vcu; U < 512; U += F.G) {
            const int b = U >> 6, h = (U >> 3) & 7, qb = U & 7; const int row0 = b * SEQ + qb * 256;
            att::UnitH u{Q + (size_t)row0 * 768 + h * 96, 768, KV + h * 128, 1024, KR, 32, KV + h * 128 + 64, 1024, O + (size_t)row0 * DM + h * 64, DM, NLAT + b * CTXL, 4, b * SEQ, 32, 0, 0, 0.f, 0.f, 0.f, nullptr};
            att::unit_hi<6, 2, false, false, false>(u, ring, F.wave);
        }
        for (int rep_ = 0; rep_ < P4REP_SWA; ++rep_)
        for (int U = vcu; U < 512; U += F.G) {
            const int b = U >> 6, h = (U >> 3) & 7, qb = U & 7; const int row0 = b * SEQ + qb * 256; const int kvh = h >> 2;
            const int klo = qb * 256 - 128 < 0 ? 0 : qb * 256 - 128, khi = qb * 256 + 384 > SEQ ? SEQ : qb * 256 + 384;
            att::UnitH u{QS + (size_t)row0 * 512 + h * 64, 512, KS + kvh * 64, 128, KS, 128, VS + kvh * 64, 128, O + (size_t)row0 * DM + 512 + h * 64, DM, NLAT + b * CTXL, 4, b * SEQ + klo, (khi - klo) >> 6, qb * 256, klo, TT(wa_sink)[h] * 1.4426950408889634f, 0.f, 0.f, nullptr};
            att::unit_hi<4, 2, true, true, false>(u, ring, F.wave);
        }
        for (int U = vcu; U < 128; U += F.G) {
            const int b = (U & 63) >> 3, h = U & 7; const int row0 = NLAT + b * CTXL;
            if (U < 64) { att::UnitH u{Q + (size_t)row0 * 768 + h * 96, 768, KV + h * 128, 1024, KR, 32, KV + h * 128 + 64, 1024, O + (size_t)row0 * DM + h * 64, DM, row0, 4, 0, 0, 0, 0, 0.f, 0.f, 0.f, nullptr};
                att::unit_hi<6, 2, false, false, false>(u, ring, F.wave); }
            else { const int kvh = h >> 2; att::UnitH u{QS + (size_t)row0 * 512 + h * 64, 512, KS + kvh * 64, 128, KS, 128, VS + kvh * 64, 128, O + (size_t)row0 * DM + 512 + h * 64, DM, row0, 4, 0, 0, 0, 0, TT(wa_sink)[h] * 1.4426950408889634f, 0.f, 0.f, nullptr};
                att::unit_hi<4, 2, true, true, false>(u, ring, F.wave); }
        }
    ) SEAM(4);
    PHASE(5,
        pg8::Gemm g{(const bf16*)(ws + R_O), (const bf16*)(ws + WS_WOUT0), DM}; pg8::StaticOrderSplit S; S.init(NT, DM, F.G, cx);
        EpiOutProjT<true> E{TT(x), TT(ctx), nullptr, (bf16*)(ws + R_HB), MOD0};
        pg8::gemm_phase<EpiOutProjT<true>, pg8::StaticOrderSplit, true, false>(ring, g, S, E, F.wave);
    ) SEAM(5);
    PHASE(6,  if ((vcu_of(F) & 1) && !dry_) { convert_expert_weights(F, 0); __syncthreads(); route_phase(F, 0, NT, dry_); } else { route_phase(F, 0, NT, dry_); if (!dry_) convert_expert_weights(F, 0); } ) SEAM(6);
#if MOE_FUSED
    PHASE(7,  moe_fused_phase(F, 0, NT, MOD0, dry_); ) SEAM(7);
    SEAM(8);
#else
    PHASE(7,  moe_gemm1_phase(F, 0, NT); ) SEAM(7);
    PHASE(8,  moe_gemm2_phase(F, 0, NT, MOD0, dry_); ) SEAM(8);
#endif
    PHASE(9,  combine_phase(F, 0, NT, dry_); ) SEAM(9);
    PHASE(10,
        pg8::Gemm g{(const bf16*)(ws + R_A1), (const bf16*)(ws + WS_WIN1), DM}; pg8::StaticOrderSplit S; S.init(NT, 3072, F.G, cx);
        EpiInProj1 E{(bf16*)(ws + R_P1), R64};
        pg8::gemm_phase<EpiInProj1, pg8::StaticOrderSplit, true, false>(ring, g, S, E, F.wave);
    ) SEAM(10);
    PHASE(11,
        const bf16* P1 = (const bf16*)(ws + R_P1);
        const int lane_ = FLANE; const float lam_init = 0.8f - 0.6f * 0.7408182206817179f;
        const float d1 = wave_sum(TT(lam_q1)[lane_] * TT(lam_k1)[lane_]); const float d2 = wave_sum(TT(lam_q2)[lane_] * TT(lam_k2)[lane_]);
        const float lam = expf(d1) - expf(d2) + lam_init;
        for (int U = vcu; U < 1024; U += F.G) {
            const int q16 = U & 15, h = (U >> 4) & 7, b = U >> 7;
            const int qrow0 = b * SEQ + q16 * 128;
            att::UnitH u{P1 + (size_t)qrow0 * 3072 + h * 384, 3072, P1 + h * 384 + 128, 3072, P1, 3072, P1 + h * 384 + 256, 3072, (bf16*)(ws + R_O1) + (size_t)qrow0 * DM + h * 128, DM, NLAT + b * CTXL, 4, b * SEQ, 32, 0, 0, 0.f, lam, 1.f - lam_init, TT(gc_sub)};
            att::unit_hi<4, 4, false, false, true>(u, ring, F.wave);
        }
    ) SEAM(11);
    PHASE(13,
        pg8::Gemm g{(const bf16*)(ws + R_O1), (const bf16*)(ws + WS_WOUT1), DM}; pg8::StaticOrder S; S.init(NLAT, DM, F.G, cx);
        EpiOutProjT<false> E{nullptr, nullptr, (const bf16*)(ws + R_HB), (bf16*)(ws + R_HB), MOD1};
        pg8::gemm_phase<EpiOutProjT<false>, pg8::StaticOrder, true, false>(ring, g, S, E, F.wave);
    ) SEAM(13);
    PHASE(14,  if ((vcu_of(F) & 1) && !dry_) { convert_expert_weights(F, 1); __syncthreads(); route_phase(F, 1, NLAT, dry_); } else { route_phase(F, 1, NLAT, dry_); if (!dry_) convert_expert_weights(F, 1); } ) SEAM(14);
#if MOE_FUSED
    PHASE(15,  moe_fused_phase(F, 1, NLAT, MOD1, dry_); ) SEAM(15);
    SEAM(16);
#else
    PHASE(15,  moe_gemm1_phase(F, 1, NLAT); ) SEAM(15);
    PHASE(16,  moe_gemm2_phase(F, 1, NLAT, MOD1, dry_); ) SEAM(16);
#endif
    PHASE(17,  combine_phase(F, 1, NLAT, dry_); )
#undef IN
#undef SEAM
}

extern "C" void kernel_launch(void* const* d_in, const int* in_sizes, int n_in, void* d_out, int out_size, void* d_ws, size_t ws_size, hipStream_t stream) {
    static int grid = 0;
    if (grid == 0) {
        if (n_in != 31 || in_sizes[0] != NLAT * DM || out_size != NLAT * DM || ws_size < WS_END) {
            fprintf(stderr, "kernel_launch: unexpected shapes: n_in %d in0 %d out %d ws %zu (need %zu); nothing launched\n", n_in, n_in > 0 ? in_sizes[0] : -1, out_size, ws_size, (size_t)WS_END); grid = -1; return; }
        int dev = 0, cus = 0;
        if (hipGetDevice(&dev) != hipSuccess || hipDeviceGetAttribute(&cus, hipDeviceAttributeMultiprocessorCount, dev) != hipSuccess) { grid = -1; return; }
        if (hipFuncSetAttribute((const void*)mk_fwd, hipFuncAttributeMaxDynamicSharedMemorySize, LDS_BYTES) != hipSuccess) { fprintf(stderr, "kernel_launch: hipFuncSetAttribute failed\n"); grid = -1; return; }
        int per_cu = 0;
        if (hipOccupancyMaxActiveBlocksPerMultiprocessor(&per_cu, (const void*)mk_fwd, 512, LDS_BYTES) != hipSuccess || per_cu < 1) fprintf(stderr, "kernel_launch: occupancy query says %d blocks per CU\n", per_cu);
        (void)hipGetLastError();
        grid = cus;
    }
    if (grid < 0) return;
    (void)hipMemsetAsync((char*)d_ws + WS_CTL, 0, CTL_ZERO_BYTES, stream);
    Args a{};
    const float** tp = (const float**)&a.T;
    for (int i = 0; i < 31; ++i) tp[i] = (const float*)d_in[i];
    a.T.out = (float*)d_out; a.T.ws = (unsigned char*)d_ws;
    if (MK_SINGLE) { a.ph_lo = 0; a.ph_hi = NPH; a.li = 0; hipLaunchKernelGGL(mk_fwd, dim3(grid), dim3(512), LDS_BYTES, stream, a); }
    else { for (int p = 0; p < NPH; ++p) { a.ph_lo = p; a.ph_hi = p + 1; a.li = p; hipLaunchKernelGGL(mk_fwd, dim3(grid), dim3(512), LDS_BYTES, stream, a); } }
    const hipError_t le = hipPeekAtLastError();
    if (le != hipSuccess) fprintf(stderr, "kernel_launch: launch failed: %s\n", hipGetErrorName(le));
}
```
